# Optimizing an MI355X kernel written in HIP

```python
import math
import jax
import jax.numpy as jnp
from jax import lax
import numpy as np

D_MODEL = 1024
BATCH = 8
SEQ = 4096
DEPTH = 2

S5_WIDTH = D_MODEL // 2
S5_GROUP_SIZE = 16
S5_GROUPS = S5_WIDTH // S5_GROUP_SIZE
S5_STATE = 64
S5_DT_MIN = 1e-3
S5_DT_MAX = 1e-1
POOL_WIDTH = D_MODEL // 2
POOL_WINDOWS = (2, 4, 8, 16)
POOL_GROUP_SIZE = POOL_WIDTH // len(POOL_WINDOWS)
ATTN_HEADS = 16
HEAD_DIM = 64
ATTN_WIDTH = ATTN_HEADS * HEAD_DIM
ATTN_PATTERNS = ((128, 1), (512, 4), (2048, 16))
ATTN_BLOCK = 64
N_BRANCHES = 3
IN_WIDTH = S5_WIDTH + POOL_WIDTH + 3 * ATTN_WIDTH + N_BRANCHES * D_MODEL
D_FF = 4 * D_MODEL
NORM_EPS = 1e-6
NEG_INF = -1e30

kernel_name = 'hybrid_s5_pool_dilated_attn_encoder'


def rmsnorm(x, g):
    xf = x.astype(jnp.float32)
    y = xf * lax.rsqrt(jnp.mean(xf * xf, axis=-1, keepdims=True) + NORM_EPS)
    return (y * g.astype(jnp.float32)).astype(x.dtype)


def _diag_recurrence(e1, e2):
    a1, b1 = e1
    a2, b2 = e2
    return a1 * a2, a2 * b1 + b2


def s5_direction(ug, lam_re, lam_im, log_dt, b_re, b_im, c_re, c_im, reverse):
    f32 = jnp.float32
    L = ug.shape[1]
    lam = lax.complex(lam_re.astype(f32), lam_im.astype(f32))
    dt = jnp.exp(log_dt.astype(f32))[:, None]
    a_bar = jnp.exp(lam * dt)
    b = lax.complex(b_re.astype(f32), b_im.astype(f32))
    b_bar = ((a_bar - 1.0) / lam)[:, :, None] * b
    bu = jnp.einsum('blgp,gnp->blgn', ug.astype(jnp.complex64), b_bar)
    if reverse:
        bu = jnp.flip(bu, axis=1)
    a_seq = jnp.broadcast_to(a_bar[None, None], (1, L) + a_bar.shape)
    _, states = lax.associative_scan(_diag_recurrence, (a_seq, bu), axis=1)
    if reverse:
        states = jnp.flip(states, axis=1)
    c = lax.complex(c_re.astype(f32), c_im.astype(f32))
    return jnp.einsum('blgn,gpn->blgp', states, c).real


def s5_mixer(u, lam_re, lam_im, log_dt, b_re, b_im, c_re, c_im, d_skip, w_glu):
    bsz, L, _ = u.shape
    uf = u.astype(jnp.float32)
    ug = uf.reshape(bsz, L, S5_GROUPS, S5_GROUP_SIZE)
    y_fwd = s5_direction(ug, lam_re[0], lam_im[0], log_dt[0], b_re[0], b_im[0], c_re[0], c_im[0], False)
    y_bwd = s5_direction(ug, lam_re[1], lam_im[1], log_dt[1], b_re[1], b_im[1], c_re[1], c_im[1], True)
    y = (y_fwd + y_bwd).reshape(bsz, L, S5_WIDTH) + d_skip.astype(jnp.float32) * uf
    y = jax.nn.gelu(y)
    y = y * jax.nn.sigmoid(y @ w_glu.astype(jnp.float32))
    return y.astype(u.dtype)


def pool_mixer(u, w_group, scale):
    bsz, L, _ = u.shape
    ng = len(POOL_WINDOWS)
    uf = u.astype(jnp.float32).reshape(bsz, L, ng, POOL_GROUP_SIZE)
    cs = jnp.concatenate([jnp.zeros((bsz, 1, ng, POOL_GROUP_SIZE), jnp.float32),
                          jnp.cumsum(uf, axis=1)], axis=1)
    t = jnp.arange(L)
    outs = []
    for g, win in enumerate(POOL_WINDOWS):
        left = win // 2
        right = win - 1 - left
        hi = jnp.minimum(t + right + 1, L)
        lo = jnp.maximum(t - left, 0)
        csg = cs[:, :, g]
        window_sum = jnp.take(csg, hi, axis=1) - jnp.take(csg, lo, axis=1)
        mean = window_sum / (hi - lo).astype(jnp.float32)[None, :, None]
        outs.append(mean - uf[:, :, g])
    pooled = jnp.stack(outs, axis=2)
    mixed = jnp.einsum('blgc,gcd->blgd', pooled, w_group.astype(jnp.float32))
    return (mixed.reshape(bsz, L, POOL_WIDTH) * scale.astype(jnp.float32)).astype(u.dtype)


def alibi_slopes(n_heads):
    return jnp.exp2(-8.0 * jnp.arange(1, n_heads + 1, dtype=jnp.float32) / n_heads)


def dilated_band(q, k, v, window, dil, slopes):
    bsz, L, H, E = q.shape
    radius = (window // 2) // dil
    QB = ATTN_BLOCK
    M = L // dil
    nb = -(-M // QB)
    Mp = nb * QB

    def by_residue(t):
        return t.reshape(bsz, M, dil, H, E).transpose(0, 2, 1, 3, 4)

    pad5 = lambda lo, hi: ((0, 0), (0, 0), (lo, hi), (0, 0), (0, 0))
    qb = jnp.pad(by_residue(q), pad5(0, Mp - M)).reshape(bsz, dil, nb, QB, H, E)
    kp = jnp.pad(by_residue(k), pad5(QB, Mp - M + QB)).reshape(bsz, dil, nb + 2, QB, H, E)
    vp = jnp.pad(by_residue(v), pad5(QB, Mp - M + QB)).reshape(bsz, dil, nb + 2, QB, H, E)
    kb = jnp.concatenate([kp[:, :, :-2], kp[:, :, 1:-1], kp[:, :, 2:]], axis=3)
    vb = jnp.concatenate([vp[:, :, :-2], vp[:, :, 1:-1], vp[:, :, 2:]], axis=3)

    a = jnp.arange(QB)
    c = jnp.arange(3 * QB)
    rel = c[None, :] - QB - a[:, None]
    key_m = jnp.arange(nb)[:, None] * QB + c[None, :] - QB
    valid = (jnp.abs(rel) <= radius)[None] & ((key_m >= 0) & (key_m < M))[:, None, :]
    dist = (dil * jnp.abs(rel)).astype(jnp.float32)

    scores = jnp.einsum('bdiqhe,bdikhe->bdihqk', qb, kb)
    scores = scores - slopes[:, None, None] * dist[None]
    scores = jnp.where(valid[None, None, :, None], scores, NEG_INF)
    mx = jnp.max(scores, axis=-1)
    p = jnp.exp(scores - mx[..., None])
    den = jnp.sum(p, axis=-1)
    num = jnp.einsum('bdihqk,bdikhe->bdiqhe', p, vb)

    num = num.reshape(bsz, dil, Mp, H, E)[:, :, :M].transpose(0, 2, 1, 3, 4).reshape(bsz, L, H, E)

    def back(s):
        s = s.transpose(0, 1, 2, 4, 3).reshape(bsz, dil, Mp, H)[:, :, :M]
        return s.transpose(0, 2, 1, 3).reshape(bsz, L, H)

    return num, back(mx), back(den)


def dilated_attention(qkv):
    bsz, L, _ = qkv.shape
    q, k, v = jnp.split(qkv.astype(jnp.float32), 3, axis=-1)
    q = q.reshape(bsz, L, ATTN_HEADS, HEAD_DIM) * (HEAD_DIM ** -0.5)
    k = k.reshape(bsz, L, ATTN_HEADS, HEAD_DIM)
    v = v.reshape(bsz, L, ATTN_HEADS, HEAD_DIM)
    slopes = alibi_slopes(ATTN_HEADS)
    nums, mxs, dens = [], [], []
    for window, dil in ATTN_PATTERNS:
        num, mx, den = dilated_band(q, k, v, window, dil, slopes)
        nums.append(num)
        mxs.append(mx)
        dens.append(den)
    mxs = jnp.stack(mxs)
    w = jnp.exp(mxs - jnp.max(mxs, axis=0, keepdims=True))
    total_num = jnp.sum(w[..., None] * jnp.stack(nums), axis=0)
    total_den = jnp.sum(w * jnp.stack(dens), axis=0)
    out = total_num / total_den[..., None]
    return out.reshape(bsz, L, ATTN_WIDTH).astype(qkv.dtype)


def setup_inputs(seed: int = 0) -> dict:
    key = jax.random.key(seed)
    ks = jax.random.split(key, 24)
    f32 = jnp.float32

    def nrm(k, shape, scale):
        return jax.random.normal(k, shape, f32) * scale

    G, N, P = S5_GROUPS, S5_STATE, S5_GROUP_SIZE
    n_idx = jnp.arange(N, dtype=f32)
    return {
        'x': nrm(ks[0], (BATCH, SEQ, D_MODEL), 1.0),
        'norm_mix': 1.0 + nrm(ks[1], (DEPTH, D_MODEL), 0.02),
        'w_in': nrm(ks[2], (DEPTH, D_MODEL, IN_WIDTH), D_MODEL ** -0.5),
        's5_lam_re': -0.5 + nrm(ks[3], (DEPTH, 2, G, N), 0.01),
        's5_lam_im': math.pi * n_idx + nrm(ks[4], (DEPTH, 2, G, N), 0.01),
        's5_log_dt': jax.random.uniform(ks[5], (DEPTH, 2, G), f32, math.log(S5_DT_MIN), math.log(S5_DT_MAX)),
        's5_b_re': nrm(ks[6], (DEPTH, 2, G, N, P), (2 * P) ** -0.5),
        's5_b_im': nrm(ks[7], (DEPTH, 2, G, N, P), (2 * P) ** -0.5),
        's5_c_re': nrm(ks[8], (DEPTH, 2, G, P, N), N ** -0.5),
        's5_c_im': nrm(ks[9], (DEPTH, 2, G, P, N), N ** -0.5),
        's5_d': nrm(ks[10], (DEPTH, S5_WIDTH), 1.0),
        's5_w_glu': nrm(ks[11], (DEPTH, S5_WIDTH, S5_WIDTH), S5_WIDTH ** -0.5),
        'pool_w': nrm(ks[12], (DEPTH, len(POOL_WINDOWS), POOL_GROUP_SIZE, POOL_GROUP_SIZE), POOL_GROUP_SIZE ** -0.5),
        'pool_scale': 1.0 + nrm(ks[13], (DEPTH, POOL_WIDTH), 0.1),
        'w_branch_s5': nrm(ks[14], (DEPTH, S5_WIDTH, D_MODEL), S5_WIDTH ** -0.5),
        'w_branch_pool': nrm(ks[15], (DEPTH, POOL_WIDTH, D_MODEL), POOL_WIDTH ** -0.5),
        'w_branch_attn': nrm(ks[16], (DEPTH, ATTN_WIDTH, D_MODEL), ATTN_WIDTH ** -0.5),
        'w_out': nrm(ks[17], (DEPTH, D_MODEL, D_MODEL), D_MODEL ** -0.5),
        'norm_mlp': 1.0 + nrm(ks[18], (DEPTH, D_MODEL), 0.02),
        'w_up': nrm(ks[19], (DEPTH, D_MODEL, D_FF), D_MODEL ** -0.5),
        'w_down': nrm(ks[20], (DEPTH, D_FF, D_MODEL), D_FF ** -0.5),
        'norm_final': 1.0 + nrm(ks[21], (D_MODEL,), 0.02),
    }


def reference(x, norm_mix, w_in, s5_lam_re, s5_lam_im, s5_log_dt, s5_b_re, s5_b_im,
              s5_c_re, s5_c_im, s5_d, s5_w_glu, pool_w, pool_scale, w_branch_s5,
              w_branch_pool, w_branch_attn, w_out, norm_mlp, w_up, w_down, norm_final):
    bsz, L, _ = x.shape
    split_at = [S5_WIDTH, S5_WIDTH + POOL_WIDTH, S5_WIDTH + POOL_WIDTH + 3 * ATTN_WIDTH]
    h = x
    for l in range(DEPTH):
        xn = rmsnorm(h, norm_mix[l])
        proj = xn @ w_in[l]
        u_s5, u_pool, qkv, gate_logits = jnp.split(proj, split_at, axis=-1)
        y_s5 = s5_mixer(u_s5, s5_lam_re[l], s5_lam_im[l], s5_log_dt[l], s5_b_re[l], s5_b_im[l],
                        s5_c_re[l], s5_c_im[l], s5_d[l], s5_w_glu[l])
        y_pool = pool_mixer(u_pool, pool_w[l], pool_scale[l])
        y_attn = dilated_attention(qkv)
        gates = jax.nn.sigmoid(gate_logits).reshape(bsz, L, N_BRANCHES, D_MODEL)
        merged = (gates[:, :, 0] * (y_s5 @ w_branch_s5[l])
                  + gates[:, :, 1] * (y_pool @ w_branch_pool[l])
                  + gates[:, :, 2] * (y_attn @ w_branch_attn[l]))
        h = h + merged @ w_out[l]
        hn = rmsnorm(h, norm_mlp[l])
        h = h + jnp.square(jax.nn.relu(hn @ w_up[l])) @ w_down[l]
    return rmsnorm(h, norm_final)
```

```cpp
#include <hip/hip_runtime.h>
#include <hip/hip_cooperative_groups.h>
#include <cstdio>
#include <cstdint>
namespace cg = cooperative_groups;

#ifndef ONE_LAUNCH
#define ONE_LAUNCH 1
#endif

#define LAS __attribute__((address_space(3)))
#define PG8_LAS __attribute__((address_space(3)))
typedef unsigned short bf16_t;
typedef short bf16x8 __attribute__((ext_vector_type(8)));
typedef float f32x4 __attribute__((ext_vector_type(4)));
typedef float f32x2 __attribute__((ext_vector_type(2)));
typedef unsigned u32x4 __attribute__((ext_vector_type(4)));
typedef unsigned u32x2 __attribute__((ext_vector_type(2)));

constexpr int NB = 8, SEQ = 4096, DM = 1024, MTOK = NB * SEQ, DFF = 4096, NLAYER = 2;
constexpr float NORM_EPS = 1e-6f;
constexpr float LOG2E = 1.4426950408889634f;
constexpr float QSCALE = 0.125f * LOG2E;
constexpr int LC = 32;
constexpr int AS5_PITCH = 768;

constexpr size_t MiB = (size_t)1 << 20;
constexpr size_t WS_W = 1 * MiB, W_LAYER_STRIDE = 37 * MiB;
constexpr size_t W_IN = 0, W_GLU = 7340032, W_BS = 7602176, W_BP = 8126464, W_BA = 8650752, W_OUT = 9699328, W_UP = 10747904, W_DN = 14942208;
constexpr size_t WS_T = 75 * MiB, WS_W1 = 99 * MiB, WS_XN = 107 * MiB, WS_UPOOL = 171 * MiB, WS_AS5 = 203 * MiB, WS_Q = 251 * MiB, WS_K = 315 * MiB, WS_VT = 379 * MiB,
                 WS_SST = 443 * MiB, WS_END = 475 * MiB;
constexpr size_t WS_POOLED = WS_K, WS_YS5 = WS_K + 32 * MiB, WS_GT = WS_VT, WS_MERGED = WS_UPOOL, WS_Y = WS_SST, WS_HID = WS_UPOOL;
constexpr int LDS_BYTES = 135168;

struct Args { const float* in[22]; float* out; unsigned char* ws; int ph_lo, ph_hi; };
typedef const __attribute__((address_space(4))) Args* KArgP;

typedef __bf16 bf16x2_t __attribute__((ext_vector_type(2)));
__device__ __forceinline__ unsigned cvt_pk_bf16(float lo, float hi) { const f32x2 v = {lo, hi}; const bf16x2_t b = __builtin_convertvector(v, bf16x2_t); return __builtin_bit_cast(unsigned, b); }
__device__ __forceinline__ u32x4 pack8(f32x4 a, f32x4 b) { u32x4 w; w.x = cvt_pk_bf16(a[0], a[1]); w.y = cvt_pk_bf16(a[2], a[3]); w.z = cvt_pk_bf16(b[0], b[1]); w.w = cvt_pk_bf16(b[2], b[3]); return w; }
__device__ __forceinline__ float bf_lo(unsigned w) { return __uint_as_float(w << 16); }
__device__ __forceinline__ float bf_hi(unsigned w) { return __uint_as_float(w & 0xffff0000u); }
__device__ __forceinline__ void unpack8(u32x4 w, f32x4& a, f32x4& b) { a = (f32x4){bf_lo(w.x), bf_hi(w.x), bf_lo(w.y), bf_hi(w.y)}; b = (f32x4){bf_lo(w.z), bf_hi(w.z), bf_lo(w.w), bf_hi(w.w)}; }
__device__ __forceinline__ float fast_sigmoid(float x) { return __builtin_amdgcn_rcpf(1.0f + __builtin_amdgcn_exp2f(-LOG2E * x)); }
__device__ __forceinline__ f32x4 sig4(f32x4 v) { return (f32x4){fast_sigmoid(v[0]), fast_sigmoid(v[1]), fast_sigmoid(v[2]), fast_sigmoid(v[3])}; }
__device__ __forceinline__ float gelu_tanh(float y) { const float u = 0.7978845608028654f * (y + 0.044715f * y * y * y); return y * fast_sigmoid(2.0f * u); }
__device__ __forceinline__ f32x4 gelu4(f32x4 v) { return (f32x4){gelu_tanh(v[0]), gelu_tanh(v[1]), gelu_tanh(v[2]), gelu_tanh(v[3])}; }
__device__ __forceinline__ float shx(float v, int o, int lane) { return __int_as_float(__builtin_amdgcn_ds_bpermute((lane ^ o) << 2, __float_as_int(v))); }
__device__ __forceinline__ float wave_sum(float v, int lane) {
#pragma unroll
    for (int o = 1; o < 64; o <<= 1) v += shx(v, o, lane);
    return v;
}

namespace pg8 {
constexpr int BM = 256, BK = 64, HALF = 128, HTB = HALF * BK * 2, STAGE_BYTES = 8 * HTB, NXCD = 8, WGM = 8;
__host__ __device__ __forceinline__ int lds_byte(int r, int c) { const int st = (r >> 4) * 2 + (c >> 5), rr = r & 15, cc = c & 31, ob = rr * 64 + cc * 2; return st * 1024 + (ob ^ (((ob >> 9) & 1) << 5)); }
__host__ __device__ __forceinline__ void stage_rc(int b, int& R, int& C) { const int st = b / 1024, sb = b % 1024, swz = sb ^ (((sb >> 9) & 1) << 5); R = (st >> 1) * 16 + swz / 64; C = (st & 1) * 32 + (swz % 64) / 2; }
__host__ __device__ __forceinline__ int perm32(int rho) { const int n = rho >> 4, i = rho & 15; return 8 * (i >> 2) + 4 * n + (i & 3); }

struct Unit { int pm, pn; const char* a; const char* b; };
struct Gemm { int K, lda, ldb; };

template <int NM, int NN, int NMZ, int BDIV, unsigned AZ, unsigned AT, unsigned BZ, unsigned BLO, unsigned BHI>
struct SchedT {
    int G, c; const char* A; const char* B;
    __device__ __forceinline__ bool next(int i, Unit& u) const {
        constexpr int nwg = NM * NN;
        const int L = i * G + c; if (L >= nwg) return false;
        int wgid = L; { constexpr int q = nwg / NXCD, r = nwg % NXCD; const int xcd = wgid % NXCD, off = wgid / NXCD; wgid = (xcd < r ? xcd * (q + 1) : r * (q + 1) + (xcd - r) * q) + off; }
        constexpr int nig = WGM * NN; const int gid = wgid / nig, fm = gid * WGM, gsz = (NM - fm) < WGM ? (NM - fm) : WGM;
        u.pm = fm + ((wgid % nig) % gsz); u.pn = (wgid % nig) / gsz;
        const int z = u.pm / NMZ, pmz = u.pm - z * NMZ;
        u.a = A + (size_t)z * AZ + (size_t)pmz * AT;
        u.b = B + (size_t)z * BZ + (size_t)(u.pn / BDIV) * BHI + (size_t)(u.pn % BDIV) * BLO;
        return true;
    }
    __device__ __forceinline__ void a_ready(const Unit&) const {}
    __device__ __forceinline__ void done(const Unit&) const {}
};

struct EpiBuf { u32x4 a, b; };
template <class F> struct EpiT {
    static constexpr bool PERM = true, AFTER_DRAIN = false; F f;
    __device__ __forceinline__ void operator()(const f32x4 (&acc)[2][2][4][2], const Unit& u, int wr, int wc, int fr, int fq) const {
#pragma unroll
        for (int ai = 0; ai < 2; ++ai) {
            EpiBuf buf[4][2];
            if constexpr (F::NLOAD > 0) {
#pragma unroll
                for (int m = 0; m < 4; ++m)
#pragma unroll
                    for (int bj = 0; bj < 2; ++bj) f.load(u.pm * BM + ai * HALF + wr * 64 + m * 16 + fr, u.pn * BM + bj * HALF + wc * 32 + 8 * fq, buf[m][bj]);
            }
#pragma unroll
            for (int m = 0; m < 4; ++m)
#pragma unroll
                for (int bj = 0; bj < 2; ++bj) f.apply(u.pm * BM + ai * HALF + wr * 64 + m * 16 + fr, u.pn * BM + bj * HALF + wc * 32 + 8 * fq, acc[ai][bj][m][0], acc[ai][bj][m][1], buf[m][bj]);
            asm volatile("" ::: "memory");
        }
    }
    __device__ __forceinline__ void fused(f32x4 (&)[2][2][4][2], const Unit&, int, int, int, int, PG8_LAS unsigned char*, int, int) const {}
};

template <class Epi, class Sched, bool ALIGN_EPI = false, bool SP2 = false>
__device__ __forceinline__ void gemm_phase(PG8_LAS unsigned char* lds, const Gemm g, const Sched& S, const Epi& E, const int tid) {
    const int  wid = __builtin_amdgcn_readfirstlane(tid >> 6), lane = tid & 63, wr = wid >> 2, wc = wid & 3, fr = lane & 15, fq = lane >> 4;
    const int K = g.K, nt = K / BK;
    unsigned voffA[2], voffB[2];
#pragma unroll
    for (int i = 0; i < 2; ++i) { int R, C; stage_rc(tid * 16 + i * 8192, R, C); const int Rb = Epi::PERM ? ((R & ~31) + perm32(R & 31)) : R;
        voffA[i] = (unsigned)(R * g.lda + C) * 2u; voffB[i] = (unsigned)(Rb * g.ldb + C) * 2u; }
    const size_t kstep = (size_t)(BK * 2);
    const size_t hstepA = (size_t)HALF * g.lda * 2, hstepB = (size_t)HALF * g.ldb * 2;
    const unsigned ldsw = (unsigned)wid * 1024u;
    const int aoff = lds_byte(wr * 64 + fr, fq * 8), boff = lds_byte(wc * 32 + fr, fq * 8);
#define PG8_SA(b, h) (((b) * 2 + (h)) * HTB)
#define PG8_SB(b, h) ((4 + (b) * 2 + (h)) * HTB)
#define PG8_STAGE(bufoff, gbase, voff) do { _Pragma("unroll") for (int _i = 0; _i < 2; ++_i) \
        __builtin_amdgcn_global_load_lds((const unsigned*)((const char*)(gbase) + (voff)[_i]), (PG8_LAS unsigned*)(lds + (bufoff) + ldsw + _i * 8192), 16, 0, 0); } while (0)
#define PG8_LDA(dst, b, h) do { _Pragma("unroll") for (int m = 0; m < 4; ++m) _Pragma("unroll") for (int k = 0; k < 2; ++k) dst[m][k] = *(const PG8_LAS bf16x8*)(lds + PG8_SA(b, h) + aoff + m * 2048 + k * 1024); } while (0)
#define PG8_LDB(dst, b, h) do { _Pragma("unroll") for (int n = 0; n < 2; ++n) _Pragma("unroll") for (int k = 0; k < 2; ++k) dst[n][k] = *(const PG8_LAS bf16x8*)(lds + PG8_SB(b, h) + boff + n * 2048 + k * 1024); } while (0)
#define PG8_MMA(ai, bj, At, Bt) do { __builtin_amdgcn_s_setprio(1); _Pragma("unroll") for (int m = 0; m < 4; ++m) _Pragma("unroll") for (int n = 0; n < 2; ++n) _Pragma("unroll") for (int k = 0; k < 2; ++k) \
        acc[ai][bj][m][n] = __builtin_amdgcn_mfma_f32_16x16x32_bf16(Bt[n][k], At[m][k], acc[ai][bj][m][n], 0, 0, 0); __builtin_amdgcn_s_setprio(0); } while (0)
#define PG8_WAIT_V(n) asm volatile("s_waitcnt vmcnt(" #n ")" ::: "memory")
#define PG8_WAIT_L(n) asm volatile("s_waitcnt lgkmcnt(" #n ")" ::: "memory")
#define PG8_BAR __builtin_amdgcn_s_barrier()
#define PG8_SCHED __builtin_amdgcn_sched_barrier(0)
    Unit cur, nxt; int ui = 0;
    if (!S.next(0, cur)) return;
    f32x4 acc[2][2][4][2];
#pragma unroll
    for (int a = 0; a < 2; ++a)
#pragma unroll
        for (int b = 0; b < 2; ++b)
#pragma unroll
            for (int m = 0; m < 4; ++m)
#pragma unroll
                for (int n = 0; n < 2; ++n) acc[a][b][m][n] = (f32x4){0.f, 0.f, 0.f, 0.f};
    bf16x8 At[4][2], B0[2][2], B1[2][2];
    const char* cA = cur.a; const char* cB = cur.b;
    S.a_ready(cur);
    if constexpr (SP2) {
        PG8_STAGE(PG8_SB(0, 0), cB, voffB); PG8_STAGE(PG8_SB(0, 1), cB + hstepB, voffB); PG8_STAGE(PG8_SA(0, 0), cA, voffA); PG8_STAGE(PG8_SA(0, 1), cA + hstepA, voffA);
        if (wr == 1) PG8_BAR;
        PG8_WAIT_V(2); PG8_BAR;
        PG8_STAGE(PG8_SB(1, 0), cB + kstep, voffB); PG8_STAGE(PG8_SA(1, 0), cA + kstep, voffA); PG8_STAGE(PG8_SB(1, 1), cB + hstepB + kstep, voffB);
        PG8_WAIT_V(6); PG8_BAR;
    } else {
        PG8_STAGE(PG8_SB(0, 0), cB, voffB); PG8_STAGE(PG8_SA(0, 0), cA, voffA); PG8_STAGE(PG8_SB(0, 1), cB + hstepB, voffB); PG8_STAGE(PG8_SA(0, 1), cA + hstepA, voffA);
        if (wr == 1) PG8_BAR;
        PG8_WAIT_V(4); PG8_BAR;
        PG8_STAGE(PG8_SB(1, 0), cB + kstep, voffB); PG8_STAGE(PG8_SA(1, 0), cA + kstep, voffA); PG8_STAGE(PG8_SB(1, 1), cB + hstepB + kstep, voffB);
        PG8_WAIT_V(6); PG8_BAR;
    }
    for (;;) {
        const bool has_next = S.next(ui + 1, nxt);
        const char* nA = has_next ? nxt.a : cA; const char* nB = has_next ? nxt.b : cB;
        for (int t = 0; t < nt; t += 2) {
            const bool last = (t == nt - 2);
            const char* a1 = cA + (size_t)(t + 1) * kstep;
            const char* a2 = last ? nA : cA + (size_t)(t + 2) * kstep; const char* b2 = last ? nB : cB + (size_t)(t + 2) * kstep;
            const char* a3 = a2 + kstep; const char* b3 = b2 + kstep;
            if (last && has_next) S.a_ready(nxt);
            if constexpr (SP2) {
            PG8_LDB(B0, 0, 0); PG8_LDB(B1, 0, 1); PG8_SCHED; PG8_LDA(At, 0, 0); PG8_STAGE(PG8_SA(1, 1), a1 + hstepA, voffA);
            PG8_WAIT_V(8); PG8_WAIT_L(0); PG8_BAR; PG8_MMA(0, 0, At, B0); PG8_MMA(0, 1, At, B1); PG8_BAR; PG8_SCHED;
            PG8_LDA(At, 0, 1); PG8_STAGE(PG8_SB(0, 0), b2, voffB); PG8_STAGE(PG8_SB(0, 1), b2 + hstepB, voffB); PG8_STAGE(PG8_SA(0, 0), a2, voffA);
            PG8_WAIT_V(8); PG8_WAIT_L(0); PG8_BAR; PG8_MMA(1, 0, At, B0); PG8_MMA(1, 1, At, B1); PG8_BAR; PG8_SCHED;
            PG8_LDB(B0, 1, 0); PG8_LDB(B1, 1, 1); PG8_SCHED; PG8_LDA(At, 1, 0); PG8_STAGE(PG8_SA(0, 1), a2 + hstepA, voffA);
            PG8_WAIT_V(8); PG8_WAIT_L(0); PG8_BAR; PG8_MMA(0, 0, At, B0); PG8_MMA(0, 1, At, B1); PG8_BAR; PG8_SCHED;
            PG8_LDA(At, 1, 1); PG8_STAGE(PG8_SB(1, 0), b3, voffB); PG8_STAGE(PG8_SB(1, 1), b3 + hstepB, voffB); PG8_STAGE(PG8_SA(1, 0), a3, voffA);
            PG8_WAIT_V(8); PG8_WAIT_L(0); PG8_BAR; PG8_MMA(1, 0, At, B0); PG8_MMA(1, 1, At, B1); PG8_BAR; PG8_SCHED;
            } else {
            PG8_LDB(B0, 0, 0); PG8_SCHED; PG8_LDA(At, 0, 0); PG8_STAGE(PG8_SA(1, 1), a1 + hstepA, voffA);
            PG8_WAIT_L(8); PG8_BAR; PG8_WAIT_L(0); PG8_MMA(0, 0, At, B0); PG8_BAR; PG8_SCHED;
            PG8_LDB(B1, 0, 1); PG8_STAGE(PG8_SB(0, 0), b2, voffB);
            PG8_BAR; PG8_WAIT_L(0); PG8_MMA(0, 1, At, B1); PG8_BAR;
            PG8_LDA(At, 0, 1); PG8_STAGE(PG8_SA(0, 0), a2, voffA);
            PG8_BAR; PG8_WAIT_L(0); PG8_MMA(1, 0, At, B0); PG8_BAR; PG8_SCHED;
            PG8_STAGE(PG8_SB(0, 1), b2 + hstepB, voffB);
            PG8_WAIT_V(6); PG8_BAR; PG8_MMA(1, 1, At, B1); PG8_BAR;
            PG8_LDB(B0, 1, 0); PG8_SCHED; PG8_LDA(At, 1, 0); PG8_STAGE(PG8_SA(0, 1), a2 + hstepA, voffA);
            PG8_WAIT_L(8); PG8_BAR; PG8_WAIT_L(0); PG8_MMA(0, 0, At, B0); PG8_BAR; PG8_SCHED;
            PG8_LDB(B1, 1, 1); PG8_STAGE(PG8_SB(1, 0), b3, voffB);
            PG8_BAR; PG8_WAIT_L(0); PG8_MMA(0, 1, At, B1); PG8_BAR;
            PG8_LDA(At, 1, 1); PG8_STAGE(PG8_SA(1, 0), a3, voffA);
            PG8_BAR; PG8_WAIT_L(0); PG8_MMA(1, 0, At, B0); PG8_BAR; PG8_SCHED;
            PG8_STAGE(PG8_SB(1, 1), b3 + hstepB, voffB);
            PG8_WAIT_V(6); PG8_BAR; PG8_MMA(1, 1, At, B1); PG8_BAR;
            }
        }
        if constexpr (ALIGN_EPI) { if (wr == 0) PG8_BAR; }
        if constexpr (!Epi::AFTER_DRAIN) { E(acc, cur, wr, wc, fr, fq); S.done(cur); }
        if (!has_next) break;
#pragma unroll
        for (int a = 0; a < 2; ++a)
#pragma unroll
            for (int b = 0; b < 2; ++b)
#pragma unroll
                for (int m = 0; m < 4; ++m)
#pragma unroll
                    for (int n = 0; n < 2; ++n) acc[a][b][m][n] = (f32x4){0.f, 0.f, 0.f, 0.f};
        cur = nxt; cA = nA; cB = nB; ++ui;
        if constexpr (ALIGN_EPI) { if (wr == 1) PG8_BAR; }
    }
    PG8_WAIT_V(0);
    if constexpr (!ALIGN_EPI) { if (wr == 0) PG8_BAR; }
    PG8_BAR;
    if constexpr (Epi::AFTER_DRAIN) { E.fused(acc, cur, wr, wc, fr, fq, lds, wid, lane); S.done(cur); }
#undef PG8_SA
#undef PG8_SB
#undef PG8_STAGE
#undef PG8_LDA
#undef PG8_LDB
#undef PG8_MMA
#undef PG8_WAIT_V
#undef PG8_WAIT_L
#undef PG8_BAR
#undef PG8_SCHED
}
}

struct FG1 { static constexpr int NLOAD = 0;
    bf16_t *as5, *upool, *q, *k;
    __device__ __forceinline__ void apply(int row, int col, f32x4 a, f32x4 b, const pg8::EpiBuf& lb) const {
        if (col < 512) { const int g = col >> 4, q0 = col & 15, bb = row >> 12, t = row & 4095, c = t >> 5, i = t & 31;
            *(u32x4*)(as5 + ((size_t)(g * 1024 + bb * 128 + c) * AS5_PITCH + i * 16 + q0)) = pack8(a, b); }
        else if (col < 1024) *(u32x4*)(upool + (size_t)row * 512 + (col - 512)) = pack8(a, b);
        else if (col < 2048) *(u32x4*)(q + (size_t)row * 1024 + (col - 1024)) = pack8(a * QSCALE, b * QSCALE);
        else { const int hd = col - 2048, h = hd >> 6, d0 = hd & 63, bb = row >> 12, t = row & 4095;
            *(u32x4*)(k + ((size_t)(((bb * 16 + h) * 16 + (t & 15)) * 256 + (t >> 4)) * 64 + d0)) = pack8(a, b); }
    }
};
struct FPlain { static constexpr int NLOAD = 0; bf16_t* o; int ldc; __device__ __forceinline__ void apply(int row, int col, f32x4 a, f32x4 b, const pg8::EpiBuf& lb) const { *(u32x4*)(o + (size_t)row * ldc + col) = pack8(a, b); } };
struct FVt { static constexpr int NLOAD = 0;
    bf16_t* v;
    __device__ __forceinline__ void apply(int row, int col, f32x4 a, f32x4 b, const pg8::EpiBuf& lb) const {
        const int h = row >> 6, d = row & 63, bb = col >> 12, rho = (col >> 8) & 15, i = col & 255;
        bf16_t* p = v + ((size_t)((((bb * 16 + h) * 16 + rho) * 64 + (i >> 2)) * 64 + d)) * 4;
        u32x2 w0, w1; w0.x = cvt_pk_bf16(a[0], a[1]); w0.y = cvt_pk_bf16(a[2], a[3]); w1.x = cvt_pk_bf16(b[0], b[1]); w1.y = cvt_pk_bf16(b[2], b[3]);
        *(u32x2*)p = w0; *(u32x2*)(p + 256) = w1; }
};
struct FS1 { static constexpr int NLOAD = 0; float* s; __device__ __forceinline__ void apply(int row, int col, f32x4 a, f32x4 b, const pg8::EpiBuf& lb) const { f32x4* p = (f32x4*)(s + (size_t)row * 256 + col); p[0] = a; p[1] = b; } };
struct FS3 { static constexpr int NLOAD = 0;
    bf16_t* y;
    __device__ __forceinline__ void apply(int row, int col, f32x4 a, f32x4 b, const pg8::EpiBuf& lb) const {
        const int g = row >> 10, bc = row & 1023, bb = bc >> 7, c = bc & 127, j = col >> 4, p0 = col & 15;
        const size_t tok = (size_t)bb * 4096 + c * 32 + j;
        *(u32x4*)(y + tok * 512 + g * 16 + p0) = pack8(gelu4(a), gelu4(b)); }
};
struct FGlu { static constexpr int NLOAD = 1; const bf16_t* y; bf16_t* o;
    __device__ __forceinline__ void load(int row, int col, pg8::EpiBuf& lb) const { lb.a = *(const u32x4*)(y + (size_t)row * 512 + col); }
    __device__ __forceinline__ void apply(int row, int col, f32x4 a, f32x4 b, const pg8::EpiBuf& lb) const {
        f32x4 ya, yb; unpack8(lb.a, ya, yb);
        *(u32x4*)(o + (size_t)row * 512 + col) = pack8(ya * sig4(a), yb * sig4(b)); }
};
struct FGate { static constexpr int NLOAD = 0; bf16_t* gt; __device__ __forceinline__ void apply(int row, int col, f32x4 a, f32x4 b, const pg8::EpiBuf& lb) const { *(u32x4*)(gt + (size_t)row * 1024 + col) = pack8(sig4(a), sig4(b)); } };
template <int MODE> struct FBranch { static constexpr int NLOAD = 2; const bf16_t* gt; bf16_t* mg;
    __device__ __forceinline__ void load(int row, int col, pg8::EpiBuf& lb) const { const size_t o = (size_t)row * 1024 + col; lb.a = *(const u32x4*)(gt + o); if (MODE) lb.b = *(const u32x4*)(mg + o); }
    __device__ __forceinline__ void apply(int row, int col, f32x4 a, f32x4 b, const pg8::EpiBuf& lb) const {
        const size_t o = (size_t)row * 1024 + col; f32x4 ga, gb; unpack8(lb.a, ga, gb);
        f32x4 va = ga * a, vb = gb * b;
        if (MODE) { f32x4 ma, mb; unpack8(lb.b, ma, mb); va += ma; vb += mb; }
        *(u32x4*)(mg + o) = pack8(va, vb); }
};
struct FResid { static constexpr int NLOAD = 2; float* h;
    __device__ __forceinline__ void load(int row, int col, pg8::EpiBuf& lb) const { const u32x4* p = (const u32x4*)(h + (size_t)row * 1024 + col); lb.a = p[0]; lb.b = p[1]; }
    __device__ __forceinline__ void apply(int row, int col, f32x4 a, f32x4 b, const pg8::EpiBuf& lb) const {
        f32x4* p = (f32x4*)(h + (size_t)row * 1024 + col); p[0] = __builtin_bit_cast(f32x4, lb.a) + a; p[1] = __builtin_bit_cast(f32x4, lb.b) + b; }
};
struct FUp { static constexpr int NLOAD = 0; bf16_t* hid;
    __device__ __forceinline__ void apply(int row, int col, f32x4 a, f32x4 b, const pg8::EpiBuf& lb) const {
        f32x4 ra, rb;
#pragma unroll
        for (int i = 0; i < 4; ++i) { const float x = fmaxf(a[i], 0.f), y = fmaxf(b[i], 0.f); ra[i] = x * x; rb[i] = y * y; }
        *(u32x4*)(hid + (size_t)row * 4096 + col) = pack8(ra, rb); }
};

template <class SC, class F> __device__ __forceinline__ void run_gemm_(LAS unsigned char* lds, const SC& S, int K, int lda, int ldb, const F& f, int tid) {
    __builtin_amdgcn_fence(__ATOMIC_ACQUIRE, "agent");
    asm volatile("" : "+v"(tid));
    pg8::Gemm g{K, lda, ldb}; pg8::EpiT<F> E{f};
    pg8::gemm_phase<pg8::EpiT<F>, SC, true, true>(lds, g, S, E, tid);
}

__device__ __forceinline__ unsigned f2bf(float f) { unsigned u = __builtin_bit_cast(unsigned, f); return (u + 0x7fffu + ((u >> 16) & 1u)) >> 16; }
__device__ __forceinline__ unsigned pk2(float lo, float hi) { return f2bf(lo) | (f2bf(hi) << 16); }
__device__ __forceinline__ void transpose_item(const float* W, int K, int N, bf16_t* WT, LAS float* scr, int item, int lane) {
    const int nblk = N / 32, kb = item / nblk, nb = item % nblk, k0 = 64 * kb, n0 = 32 * nb;
    float wv[32];
#pragma unroll
    for (int i = 0; i < 32; ++i) wv[i] = W[(size_t)(k0 + 2 * i + (lane >> 5)) * N + n0 + (lane & 31)];
#pragma unroll
    for (int i = 0; i < 32; ++i) scr[(2 * i + (lane >> 5)) * 33 + (lane & 31)] = wv[i];
    asm volatile("s_waitcnt lgkmcnt(0)" ::: "memory");
    const int c = lane & 7;
#pragma unroll
    for (int j = 0; j < 4; ++j) { const int n = (lane >> 3) + 8 * j; const LAS float* s = scr + (8 * c) * 33 + n;
        u32x4 o; o.x = pk2(s[0 * 33], s[1 * 33]); o.y = pk2(s[2 * 33], s[3 * 33]); o.z = pk2(s[4 * 33], s[5 * 33]); o.w = pk2(s[6 * 33], s[7 * 33]);
        *(u32x4*)(WT + (size_t)(n0 + n) * K + k0 + 8 * c) = o; }
    asm volatile("s_waitcnt lgkmcnt(0)" ::: "memory");
}
__device__ __forceinline__ void phase_convert(KArgP A, LAS unsigned char* lds, int gw, int NGW, int wave, int lane, int gtid, int NT) {
    LAS float* scr = (LAS float*)(lds + wave * 16384);
    for (int l = 0; l < NLAYER; ++l) {
        bf16_t* WL = (bf16_t*)(A->ws + WS_W + (size_t)l * W_LAYER_STRIDE);
        const float* srcs[7] = {A->in[2] + (size_t)l * 1024 * 7168, A->in[11] + (size_t)l * 512 * 512, A->in[14] + (size_t)l * 512 * 1024, A->in[16] + (size_t)l * 1024 * 1024,
                                A->in[17] + (size_t)l * 1024 * 1024, A->in[19] + (size_t)l * 1024 * 4096, A->in[20] + (size_t)l * 4096 * 1024};
        const int Ks[7] = {1024, 512, 512, 1024, 1024, 1024, 4096}, Ns[7] = {7168, 512, 1024, 1024, 1024, 4096, 1024};
        const size_t offs[7] = {W_IN, W_GLU, W_BS, W_BA, W_OUT, W_UP, W_DN};
#pragma unroll
        for (int w = 0; w < 7; ++w) { const int items = (Ks[w] / 64) * (Ns[w] / 32);
            for (int it = gw; it < items; it += NGW) transpose_item(srcs[w], Ks[w], Ns[w], WL + offs[w], scr, it, lane); }
        const float* pw = A->in[12] + (size_t)l * 4 * 128 * 128; const float* psc = A->in[13] + (size_t)l * 512; const float* wbp = A->in[15] + (size_t)l * 512 * 1024;
        bf16_t* WP = WL + W_BP;
        for (int e = gtid; e < 1024 * 512; e += NT) { const int k = __builtin_amdgcn_readfirstlane(e >> 10), n = e & 1023, g = k >> 7;
            const float* pr = pw + (size_t)k * 128; const float* sc = psc + g * 128; const float* wb = wbp + (size_t)(g * 128) * 1024 + n; float acc = 0.f;
#pragma unroll 8
            for (int d = 0; d < 128; ++d) acc += (pr[d] * sc[d]) * wb[(size_t)d * 1024];
            WP[(size_t)n * 512 + k] = (bf16_t)f2bf(acc); }
    }
}

template <int MODE  >
__device__ __forceinline__ void phase_norm(const float* src, const float* gain, bf16_t* xn, float* dst, int gw, int NGW, int lane) {
    f32x4 gv[4];
#pragma unroll
    for (int j = 0; j < 4; ++j) gv[j] = *((const f32x4*)gain + lane + 64 * j);
    for (int m = gw; m < MTOK; m += NGW) {
        const f32x4* xr = (const f32x4*)(src + (size_t)m * DM) + lane; f32x4 v[4]; float s = 0.f;
#pragma unroll
        for (int j = 0; j < 4; ++j) { v[j] = xr[64 * j]; s += (v[j].x * v[j].x + v[j].y * v[j].y) + (v[j].z * v[j].z + v[j].w * v[j].w); }
        const float r = 1.0f / sqrtf(wave_sum(s, lane) * (1.0f / DM) + NORM_EPS);
        if (MODE == 1) { f32x4* o = (f32x4*)(dst + (size_t)m * DM) + lane;
#pragma unroll
            for (int j = 0; j < 4; ++j) o[64 * j] = v[j]; }
        if (MODE == 2) { f32x4* o = (f32x4*)(dst + (size_t)m * DM) + lane;
#pragma unroll
            for (int j = 0; j < 4; ++j) o[64 * j] = v[j] * r * gv[j]; }
        else { u32x2* o = (u32x2*)(xn + (size_t)m * DM) + lane;
#pragma unroll
            for (int j = 0; j < 4; ++j) { const f32x4 y = v[j] * r * gv[j]; u32x2 w; w.x = cvt_pk_bf16(y.x, y.y); w.y = cvt_pk_bf16(y.z, y.w); o[64 * j] = w; } }
    }
}

__device__ __forceinline__ void sincos_d(double ang, double& s, double& c) {
    const double x = ang * 0.63661977236758134308; const double q = rint(x); const double y = (x - q) * 1.57079632679489661923; const double y2 = y * y;
    const double sp = y * (1.0 + y2 * (-1.0 / 6 + y2 * (1.0 / 120 + y2 * (-1.0 / 5040 + y2 * (1.0 / 362880 + y2 * (-1.0 / 39916800))))));
    const double cp = 1.0 + y2 * (-0.5 + y2 * (1.0 / 24 + y2 * (-1.0 / 720 + y2 * (1.0 / 40320 + y2 * (-1.0 / 3628800 + y2 * (1.0 / 479001600))))));
    const int qi = ((int)q) & 3;
    s = (qi == 0) ? sp : (qi == 1) ? cp : (qi == 2) ? -sp : -cp;
    c = (qi == 0) ? cp : (qi == 1) ? -sp : (qi == 2) ? -cp : sp;
}
__device__ __forceinline__ void a_pow(float lr, float li, float dt, int d, float& re, float& im) {
    const float mag = expf(lr * dt * (float)d); double s, c; sincos_d((double)li * (double)dt * (double)d, s, c); re = mag * (float)c; im = mag * (float)s;
}
__device__ __forceinline__ void s5_tables(KArgP A, int l, int g, int ps, LAS unsigned char* lds, int tid) {
    LAS f32x2* pw = (LAS f32x2*)lds;
    LAS f32x2* Bb = (LAS f32x2*)(lds + 33792);
    LAS float* Kt = (LAS float*)(lds + 50176);
    const float* lam_re = A->in[3]; const float* lam_im = A->in[4]; const float* log_dt = A->in[5];
    const float* b_re = A->in[6]; const float* b_im = A->in[7]; const float* c_re = A->in[8]; const float* c_im = A->in[9]; const float* dsk = A->in[10];
    for (int e = tid; e < 2 * 33 * 64; e += 512) { const int dir = e / (33 * 64), rem = e - dir * 33 * 64, d = rem >> 6, n = rem & 63; const int gi = (l * 2 + dir) * 32 + g;
        float re, im; a_pow(lam_re[gi * 64 + n], lam_im[gi * 64 + n], expf(log_dt[gi]), d, re, im); pw[e] = (f32x2){re, im}; }
    for (int e = tid; e < 2 * 64 * 16; e += 512) { const int dir = e >> 10, n = (e >> 4) & 63, q = e & 15; const int gi = (l * 2 + dir) * 32 + g;
        const float lr = lam_re[gi * 64 + n], li = lam_im[gi * 64 + n]; float ar, ai; a_pow(lr, li, expf(log_dt[gi]), 1, ar, ai);
        const double nr = (double)ar - 1.0, ni = (double)ai, den = (double)lr * lr + (double)li * li; const double cr = (nr * lr + ni * li) / den, ci = (ni * lr - nr * li) / den;
        const float br = b_re[((size_t)gi * 64 + n) * 16 + q], bi = b_im[((size_t)gi * 64 + n) * 16 + q];
        Bb[e] = (f32x2){(float)(cr * br - ci * bi), (float)(cr * bi + ci * br)}; }
    LAS f32x2* Cc = (LAS f32x2*)(lds + 58368);
    if (tid < 256) { const int dir = tid >> 7, pl = (tid >> 6) & 1, n = tid & 63; const size_t ci_ = ((size_t)((l * 2 + dir) * 32 + g) * 16 + ps * 2 + pl) * 64 + n; Cc[tid] = (f32x2){c_re[ci_], c_im[ci_]}; }
    __syncthreads();
    for (int e = tid; e < 2 * 32 * 2 * 16; e += 512) { const int dir = e >> 10, d = (e >> 5) & 31, pl = (e >> 4) & 1, q = e & 15; float acc = 0.f;
#pragma unroll 8
        for (int n = 0; n < 64; ++n) { const f32x2 w = pw[(dir * 33 + d) * 64 + n], bb = Bb[(dir * 64 + n) * 16 + q], cc = Cc[(dir * 2 + pl) * 64 + n];
            const float zr = w.x * bb.x - w.y * bb.y, zi = w.x * bb.y + w.y * bb.x; acc += cc.x * zr - cc.y * zi; }
        Kt[e] = acc; }
    __syncthreads();
    bf16_t* T = (bf16_t*)(A->ws + WS_T) + (size_t)g * 512 * AS5_PITCH;
    for (int e = tid; e < 64 * 96; e += 512) { const int rr = e / 96, kv = e - rr * 96, j = rr >> 1, pl = rr & 1, p = ps * 2 + pl, k0 = kv * 8; float v[8];
        if (k0 < 512) { const int i = k0 >> 4, q0 = k0 & 15;
#pragma unroll
            for (int t = 0; t < 8; ++t) { const int q = q0 + t; float x = 0.f;
                if (i <= j) x += Kt[((0 * 32 + (j - i)) * 2 + pl) * 16 + q];
                if (i >= j) x += Kt[((1 * 32 + (i - j)) * 2 + pl) * 16 + q];
                if (i == j && q == p) x += dsk[(size_t)l * 512 + g * 16 + p];
                v[t] = x; } }
        else { const int w = (k0 - 512) >> 6, n0 = (k0 - 512) & 63, dir = w >> 1, pidx = dir == 0 ? j + 1 : LC - j; const int gi = (l * 2 + dir) * 32 + g;
#pragma unroll
            for (int t = 0; t < 8; ++t) { const int n = n0 + t; const f32x2 cc = Cc[(dir * 2 + pl) * 64 + n]; const float cr = cc.x, ci = cc.y; const f32x2 a = pw[(dir * 33 + pidx) * 64 + n];
                v[t] = (w & 1) ? -(cr * a.y + ci * a.x) : (cr * a.x - ci * a.y); } }
        u32x4 o; o.x = pk2(v[0], v[1]); o.y = pk2(v[2], v[3]); o.z = pk2(v[4], v[5]); o.w = pk2(v[6], v[7]);
        *(u32x4*)(T + (size_t)(j * 16 + p) * AS5_PITCH + k0) = o; }
    bf16_t* W1 = (bf16_t*)(A->ws + WS_W1) + (size_t)g * 256 * 512;
    for (int e = tid; e < 32 * 64; e += 512) { const int n2 = ps * 32 + (e >> 6), kv = e & 63, k0 = kv * 8, i = k0 >> 4, q0 = k0 & 15; const int dir = n2 >> 7, isim = (n2 >> 6) & 1, n = n2 & 63;
        const int pidx = dir == 0 ? (LC - 1 - i) : i; const f32x2 a = pw[(dir * 33 + pidx) * 64 + n]; float v[8];
#pragma unroll
        for (int t = 0; t < 8; ++t) { const f32x2 bb = Bb[(dir * 64 + n) * 16 + q0 + t]; v[t] = isim ? (a.x * bb.y + a.y * bb.x) : (a.x * bb.x - a.y * bb.y); }
        u32x4 o; o.x = pk2(v[0], v[1]); o.y = pk2(v[2], v[3]); o.z = pk2(v[4], v[5]); o.w = pk2(v[6], v[7]);
        *(u32x4*)(W1 + (size_t)n2 * 512 + k0) = o; }
    __syncthreads();
}

__device__ __forceinline__ void s5_scan(KArgP A, int l, int wid  , int lane) {
    const int g = wid >> 4, b = (wid >> 1) & 7, dir = wid & 1, n = lane; const int gi = (l * 2 + dir) * 32 + g;
    float ar, ai; a_pow(A->in[3][gi * 64 + n], A->in[4][gi * 64 + n], expf(A->in[5][gi]), LC, ar, ai);
    const float* S = (const float*)(A->ws + WS_SST) + ((size_t)g * 1024 + b * 128) * 256 + dir * 128 + n;
    bf16_t* X = (bf16_t*)(A->ws + WS_AS5) + ((size_t)g * 1024 + b * 128) * AS5_PITCH + 512 + dir * 128 + n;
    float xr = 0.f, xi = 0.f;
    for (int c0 = 0; c0 < 128; c0 += 8) {
        float sr[8], si[8];
#pragma unroll
        for (int u = 0; u < 8; ++u) { const int c = dir == 0 ? (c0 + u) : (127 - c0 - u); sr[u] = S[(size_t)c * 256]; si[u] = S[(size_t)c * 256 + 64]; }
#pragma unroll
        for (int u = 0; u < 8; ++u) { const int c = dir == 0 ? (c0 + u) : (127 - c0 - u);
            X[(size_t)c * AS5_PITCH] = (bf16_t)f2bf(xr); X[(size_t)c * AS5_PITCH + 64] = (bf16_t)f2bf(xi);
            const float nr = ar * xr - ai * xi + sr[u], ni = ar * xi + ai * xr + si[u]; xr = nr; xi = ni; }
    }
}

__device__ __forceinline__ void phase_pool(const bf16_t* up, bf16_t* pooled, int gw, int NGW, int lane) {
    for (int it = gw; it < NB * 256; it += NGW) {
        const int b = it >> 8, tc = it & 255, t0 = tc * 16, grp = lane >> 4, win = 2 << grp, left = win >> 1, right = win - 1 - left;
        const bf16_t* base = up + (size_t)b * SEQ * 512 + lane * 8; bf16_t* ob = pooled + (size_t)b * SEQ * 512 + lane * 8;
        int lo = t0 - left < 0 ? 0 : t0 - left, hi = t0 + right + 1 > SEQ ? SEQ : t0 + right + 1;
        f32x4 s0 = {0.f, 0.f, 0.f, 0.f}, s1 = {0.f, 0.f, 0.f, 0.f};
        for (int s = lo; s < hi; ++s) { f32x4 a, c; unpack8(*(const u32x4*)(base + (size_t)s * 512), a, c); s0 += a; s1 += c; }
        for (int t = t0; t < t0 + 16; ++t) {
            f32x4 a, c; unpack8(*(const u32x4*)(base + (size_t)t * 512), a, c); const float inv = 1.0f / (float)(hi - lo);
            *(u32x4*)(ob + (size_t)t * 512) = pack8(s0 * inv - a, s1 * inv - c);
            if (t + right + 1 < SEQ) { f32x4 x, y; unpack8(*(const u32x4*)(base + (size_t)(t + right + 1) * 512), x, y); s0 += x; s1 += y; ++hi; }
            if (t - left >= 0) { f32x4 x, y; unpack8(*(const u32x4*)(base + (size_t)(t - left) * 512), x, y); s0 -= x; s1 -= y; ++lo; }
        }
    }
}

struct KVFrag { bf16x8 ka0, ka1, kb0, kb1; u32x2 va[4], vb[4]; };
__device__ __forceinline__ void tile_base(int tid, int r, int i0, int& rho, int& ib) {
    if (tid < 10) { const int jt = tid < 2 ? tid + 4 : (tid < 6 ? tid - 2 : tid); rho = r; ib = i0 - 64 + 16 * jt; }
    else if (tid < 22) { const int u = tid - 10, c = u / 3, uu = u - 3 * c; rho = (r + 4 * c) & 15; ib = i0 - 16 + 16 * uu; }
    else { const int v = tid - 22, rs = v / 6, w = v - 6 * rs; rho = 4 * rs; ib = i0 - 4 + 4 * w; }
}
__device__ __forceinline__ int clampi(int x, int lo, int hi) { return x < lo ? lo : (x > hi ? hi : x); }
__device__ __forceinline__ void attn_load(KVFrag& f, int pp, const bf16_t* Kb, const bf16_t* Vb, int r, int i0, int ql, int quad) {
    const int kq = ql >> 2, ks = ql & 3; const bool strided = pp < 11;
    int rho, ib;
    tile_base(2 * pp, r, i0, rho, ib);
    { const int kr = strided ? rho : rho + kq, ki = clampi(strided ? ib + ql : ib + ks, 0, 255); const bf16_t* p = Kb + (kr * 256 + ki) * 64; f.ka0 = *(const bf16x8*)p; f.ka1 = *(const bf16x8*)(p + 32);
      const int vr = strided ? rho : rho + quad, vi = clampi(strided ? ib + 4 * quad : ib, 0, 252) >> 2; const bf16_t* q = Vb + (vr * 64 + vi) * 256;
#pragma unroll
      for (int dt = 0; dt < 4; ++dt) f.va[dt] = *(const u32x2*)(q + dt * 64); }
    tile_base(2 * pp + 1, r, i0, rho, ib);
    { const int kr = strided ? rho : rho + kq, ki = clampi(strided ? ib + ql : ib + ks, 0, 255); const bf16_t* p = Kb + (kr * 256 + ki) * 64; f.kb0 = *(const bf16x8*)p; f.kb1 = *(const bf16x8*)(p + 32);
      const int vr = strided ? rho : rho + quad, vi = clampi(strided ? ib + 4 * quad : ib, 0, 252) >> 2; const bf16_t* q = Vb + (vr * 64 + vi) * 256;
#pragma unroll
      for (int dt = 0; dt < 4; ++dt) f.vb[dt] = *(const u32x2*)(q + dt * 64); }
}
struct AttnState { f32x4 o[4]; float m, lsum; };
__device__ __forceinline__ void attn_step(AttnState& st, const KVFrag& cur, int pp, bf16x8 qf0, bf16x8 qf1, int r, int i0, int tq, int quad, float nslope2, int lane) {
    const bool strided = pp < 11; const float Rf = pp < 5 ? 1024.f : (pp < 11 ? 256.f : 64.f);
    f32x4 sA = {0.f, 0.f, 0.f, 0.f}, sB = {0.f, 0.f, 0.f, 0.f};
    sA = __builtin_amdgcn_mfma_f32_16x16x32_bf16(cur.ka0, qf0, sA, 0, 0, 0); sA = __builtin_amdgcn_mfma_f32_16x16x32_bf16(cur.ka1, qf1, sA, 0, 0, 0);
    sB = __builtin_amdgcn_mfma_f32_16x16x32_bf16(cur.kb0, qf0, sB, 0, 0, 0); sB = __builtin_amdgcn_mfma_f32_16x16x32_bf16(cur.kb1, qf1, sB, 0, 0, 0);
    int rho, ib; float dA, dB;
    tile_base(2 * pp, r, i0, rho, ib); { const int rr = strided ? rho : rho + quad, ii = strided ? ib + 4 * quad : ib; dA = ((unsigned)ii < 256u) ? (float)(rr + 16 * ii - tq) : 1e9f; }
    tile_base(2 * pp + 1, r, i0, rho, ib); { const int rr = strided ? rho : rho + quad, ii = strided ? ib + 4 * quad : ib; dB = ((unsigned)ii < 256u) ? (float)(rr + 16 * ii - tq) : 1e9f; }
    float s[8]; float mx = -1e30f;
#pragma unroll
    for (int e = 0; e < 4; ++e) { const float xa = fabsf(dA + 16.f * e), xb = fabsf(dB + 16.f * e);
        s[e] = xa <= Rf ? fmaf(nslope2, xa, sA[e]) : -1e30f; s[4 + e] = xb <= Rf ? fmaf(nslope2, xb, sB[e]) : -1e30f; }
#pragma unroll
    for (int e = 0; e < 8; ++e) mx = fmaxf(mx, s[e]);
    mx = fmaxf(mx, shx(mx, 16, lane)); mx = fmaxf(mx, shx(mx, 32, lane));
    const float mn = fmaxf(st.m, mx);
    if (__builtin_amdgcn_ballot_w64(mn > st.m) != 0ull) {
        const float alpha = __builtin_amdgcn_exp2f(st.m - mn); st.m = mn; st.lsum *= alpha;
#pragma unroll
        for (int dt = 0; dt < 4; ++dt) st.o[dt] = st.o[dt] * alpha;
    }
    float p[8]; float ps = 0.f;
#pragma unroll
    for (int e = 0; e < 8; ++e) { p[e] = __builtin_amdgcn_exp2f(s[e] - mn); ps += p[e]; }
    st.lsum += ps;
    u32x4 pk; pk.x = cvt_pk_bf16(p[0], p[1]); pk.y = cvt_pk_bf16(p[2], p[3]); pk.z = cvt_pk_bf16(p[4], p[5]); pk.w = cvt_pk_bf16(p[6], p[7]);
    const bf16x8 pf = __builtin_bit_cast(bf16x8, pk);
#pragma unroll
    for (int dt = 0; dt < 4; ++dt) { u32x4 vv; vv.x = cur.va[dt].x; vv.y = cur.va[dt].y; vv.z = cur.vb[dt].x; vv.w = cur.vb[dt].y;
        st.o[dt] = __builtin_amdgcn_mfma_f32_16x16x32_bf16(__builtin_bit_cast(bf16x8, vv), pf, st.o[dt], 0, 0, 0); }
}
__device__ __forceinline__ void attn_group(const bf16_t* Q, const bf16_t* Kp, const bf16_t* Vt, bf16_t* O, int b, int h, int r, int i0, int lane) {
    const int ql = lane & 15, quad = lane >> 4;
    const int tq = r + 16 * (i0 + ql);
    const float nslope2 = -exp2f(-0.5f * (float)(h + 1)) * LOG2E;
    const size_t qrow = ((size_t)b * SEQ + tq) * 1024 + h * 64;
    const bf16x8 qf0 = *(const bf16x8*)(Q + qrow + quad * 8), qf1 = *(const bf16x8*)(Q + qrow + 32 + quad * 8);
    const bf16_t* Kb = Kp + (size_t)(b * 16 + h) * 262144 + quad * 8;
    const bf16_t* Vb = Vt + (size_t)(b * 16 + h) * 262144 + ql * 4;
    AttnState st;
#pragma unroll
    for (int dt = 0; dt < 4; ++dt) st.o[dt] = (f32x4){0.f, 0.f, 0.f, 0.f};
    st.m = -1e30f; st.lsum = 0.f;
    KVFrag fa, fb, fc;
    attn_load(fa, 0, Kb, Vb, r, i0, ql, quad); attn_load(fb, 1, Kb, Vb, r, i0, ql, quad);
    for (int pp = 0; pp < 21; pp += 3) {
        attn_load(fc, pp + 2, Kb, Vb, r, i0, ql, quad); attn_step(st, fa, pp, qf0, qf1, r, i0, tq, quad, nslope2, lane);
        attn_load(fa, pp + 3, Kb, Vb, r, i0, ql, quad); attn_step(st, fb, pp + 1, qf0, qf1, r, i0, tq, quad, nslope2, lane);
        if (pp + 4 < 23) attn_load(fb, pp + 4, Kb, Vb, r, i0, ql, quad);
        attn_step(st, fc, pp + 2, qf0, qf1, r, i0, tq, quad, nslope2, lane);
    }
    attn_step(st, fa, 21, qf0, qf1, r, i0, tq, quad, nslope2, lane); attn_step(st, fb, 22, qf0, qf1, r, i0, tq, quad, nslope2, lane);
    float lsum = st.lsum; lsum += shx(lsum, 16, lane); lsum += shx(lsum, 32, lane);
    const float inv = 1.0f / lsum;
#pragma unroll
    for (int dt = 0; dt < 4; ++dt) { u32x2 w; w.x = cvt_pk_bf16(st.o[dt][0] * inv, st.o[dt][1] * inv); w.y = cvt_pk_bf16(st.o[dt][2] * inv, st.o[dt][3] * inv);
        *(u32x2*)(O + qrow + dt * 16 + 4 * quad) = w; }
}
__device__ __forceinline__ void phase_attn(const bf16_t* Q, const bf16_t* Kp, const bf16_t* Vt, bf16_t* O, int vcu, int G, int wave, int lane) {
    const int per_x = G >> 3, xcd = vcu / per_x, j = vcu - xcd * per_x;
    const int gpr = per_x * 16;
    for (int g0 = 0; g0 < 16 * 256; g0 += gpr) {
#pragma unroll 1
        for (int k = 0; k < 2; ++k) { const int gi = g0 + j * 16 + k * 8 + wave, bh = xcd * 16 + (gi >> 8), rem = gi & 255;
            attn_group(Q, Kp, Vt, O, bh >> 4, bh & 15, rem & 15, (rem >> 4) * 16, lane); }
    }
}

#define XB_TMO      128
#define XB_XCNT(j)  (256  + 64 * (j))
#define XB_XSUB(j)  (1280 + 64 * (j))
#define XB_XGEN(j)  (2304 + 64 * (j))
#define XB_TOP      3328
#define XB_TOPGEN   3392
#define XCD_BAR_WORDS 3456
#define XB_SPIN_CAP (1u << 18)

__device__ __forceinline__ unsigned xb_ld(unsigned* p)              { return __hip_atomic_load(p, __ATOMIC_RELAXED, __HIP_MEMORY_SCOPE_AGENT); }
__device__ __forceinline__ unsigned xb_add(unsigned* p, unsigned v) { return __hip_atomic_fetch_add(p, v, __ATOMIC_RELAXED, __HIP_MEMORY_SCOPE_AGENT); }
__device__ __forceinline__ unsigned xb_xcc_id() { return (unsigned)__builtin_amdgcn_s_getreg((3 << 11) | 20) & 0xFu; }
#define XB_SPIN(cond, bar) do { unsigned _sp = 0; while (cond) { __builtin_amdgcn_s_sleep(1); \
    if ((++_sp & 255u) == 0u) { if (xb_ld(&(bar)[XB_TMO])) break; if (_sp > XB_SPIN_CAP) { atomicAdd(&(bar)[XB_TMO], 1u); break; } } } } while (0)

struct XcdBarrier {
    unsigned* bar; unsigned x;
    volatile LAS unsigned* st;
};

__device__ __forceinline__ XcdBarrier xcd_barrier_post(unsigned* bar, volatile LAS unsigned* st) {
    XcdBarrier b; b.bar = bar; b.x = xb_xcc_id(); b.st = st;
    if (threadIdx.x == 0) (void)xb_add(&bar[XB_XCNT(b.x)], 1u);
    return b;
}
__device__ __forceinline__ void xcd_barrier_complete(unsigned* bar, unsigned x, unsigned& nloc, unsigned& nx) {
    const unsigned G = gridDim.x * gridDim.y * gridDim.z;
    unsigned sum, cnt, mine, sp = 0u;
    for (;;) {
        sum = 0u; cnt = 0u; mine = 0u;
#pragma unroll
        for (unsigned j = 0; j < 16; ++j) { const unsigned c = xb_ld(&bar[XB_XCNT(j)]); sum += c; cnt += (c > 0u) ? 1u : 0u; mine = (j == x) ? c : mine; }
        if (sum == G) break;
        __builtin_amdgcn_s_sleep(1);
        if ((++sp & 255u) == 0u) { if (xb_ld(&bar[XB_TMO])) break; if (sp > XB_SPIN_CAP) { atomicAdd(&bar[XB_TMO], 1u); break; } }
    }
    nloc = mine > 0u ? mine : 1u; nx = cnt > 0u ? cnt : 1u;
}

__device__ __forceinline__ void xcd_barrier(const XcdBarrier& b) {
    asm volatile("s_waitcnt vmcnt(0)" ::: "memory");
    __syncthreads();
    if (threadIdx.x == 0) {
        unsigned* bar = b.bar;
        __builtin_amdgcn_s_waitcnt(0);
        unsigned nloc = b.st[0], nx = b.st[1];
        if (nloc == 0u) { xcd_barrier_complete(bar, b.x, nloc, nx); b.st[0] = nloc; b.st[1] = nx; }
        const unsigned old = xb_add(&bar[XB_XSUB(b.x)], 1u);
        const unsigned gen = old / nloc;
        if (old + 1u == (gen + 1u) * nloc) {
            __builtin_amdgcn_fence(__ATOMIC_RELEASE, "agent");
            asm volatile("s_waitcnt vmcnt(0)" ::: "memory");
            const unsigned og = xb_add(&bar[XB_TOP], 1u);
            const unsigned tg = og / nx;
            if (og + 1u == (tg + 1u) * nx) xb_add(&bar[XB_TOPGEN], 1u);
            else XB_SPIN(xb_ld(&bar[XB_TOPGEN]) == tg, bar);
            __builtin_amdgcn_fence(__ATOMIC_ACQUIRE, "agent");
            xb_add(&bar[XB_XGEN(b.x)], 1u);
            asm volatile("s_waitcnt vmcnt(0)" ::: "memory");
        } else {
            XB_SPIN(xb_ld(&bar[XB_XGEN(b.x)]) == gen, bar);
            __builtin_amdgcn_fence(__ATOMIC_ACQUIRE, "agent");
            asm volatile("s_waitcnt vmcnt(0)" ::: "memory");
        }
    }
    __syncthreads();
}


#define XN ((bf16_t*)(ws + WS_XN))
#define UPOOL ((bf16_t*)(ws + WS_UPOOL))
#define AS5 ((bf16_t*)(ws + WS_AS5))
#define Qb ((bf16_t*)(ws + WS_Q))
#define Kb ((bf16_t*)(ws + WS_K))
#define VT ((bf16_t*)(ws + WS_VT))
#define SST ((float*)(ws + WS_SST))
#define POOLED ((bf16_t*)(ws + WS_POOLED))
#define YS5 ((bf16_t*)(ws + WS_YS5))
#define GT ((bf16_t*)(ws + WS_GT))
#define MERGED ((bf16_t*)(ws + WS_MERGED))
#define Yb ((bf16_t*)(ws + WS_Y))
#define HID ((bf16_t*)(ws + WS_HID))
#define Tt ((bf16_t*)(ws + WS_T))
#define W1t ((bf16_t*)(ws + WS_W1))
#define run_gemm(lds, S, K, lda, ldb, ...) run_gemm_(lds, S, K, lda, ldb, __VA_ARGS__, tid)
#ifndef BR_N
#define BR_N 2
#endif
#ifndef PHMASK
#define PHMASK 0xFFFF
#endif
constexpr int NSUB = 11;
constexpr int NPH = 1 + NSUB * NLAYER + 1;
constexpr int NOB = 1 << 30;
constexpr unsigned T1K = 256u * 1024 * 2, T512 = 256u * 512 * 2, TAS5 = 256u * AS5_PITCH * 2, T4K = 256u * 4096 * 2;
typedef pg8::SchedT<MTOK / 256, 12, MTOK / 256, NOB, 0u, T1K, 0u, T1K, 0u> SchedIn;
typedef pg8::SchedT<4, MTOK / 256, 4, 16, 0u, T1K, 0u, 1024u * 2, (unsigned)SEQ * 1024 * 2> SchedVt;
typedef pg8::SchedT<128, 1, 4, NOB, 1024u * AS5_PITCH * 2, TAS5, 256u * 512 * 2, 0u, 0u> SchedS1;
typedef pg8::SchedT<128, 2, 4, NOB, 1024u * AS5_PITCH * 2, TAS5, 512u * AS5_PITCH * 2, TAS5, 0u> SchedS3;
typedef pg8::SchedT<MTOK / 256, 2, MTOK / 256, NOB, 0u, T512, 0u, T512, 0u> SchedGlu;
typedef pg8::SchedT<MTOK / 256, 4, MTOK / 256, NOB, 0u, T1K, 0u, T1K, 0u> Sched1k;
typedef pg8::SchedT<MTOK / 256, 4, MTOK / 256, NOB, 0u, T512, 0u, T512, 0u> Sched512;
typedef pg8::SchedT<MTOK / 256, 16, MTOK / 256, NOB, 0u, T1K, 0u, T1K, 0u> SchedUp;
typedef pg8::SchedT<MTOK / 256, 4, MTOK / 256, NOB, 0u, T4K, 0u, T4K, 0u> SchedDn;
#define CP(x) ((const char*)(x))
__global__ void __launch_bounds__(512, 2) fwd_kernel(Args Araw) {
    extern __shared__ __attribute__((aligned(16))) unsigned char lds_raw[];
    LAS unsigned char* lds = (LAS unsigned char*)lds_raw;
    const int ph_hi = Araw.ph_hi; const int wave0 = __builtin_amdgcn_readfirstlane(threadIdx.x >> 6);
    volatile LAS unsigned* bst = (volatile LAS unsigned*)(lds + 131072 + 64);
    if (threadIdx.x < 2) bst[threadIdx.x] = 0u;
    __syncthreads();
    XcdBarrier xbar; xbar.bar = (unsigned*)Araw.ws; xbar.x = 0; xbar.st = bst;
    if (ph_hi - Araw.ph_lo > 1) xbar = xcd_barrier_post((unsigned*)Araw.ws, bst);
    for (int ph = Araw.ph_lo; ph < ph_hi; ++ph) {
        KArgP A = (KArgP)__builtin_amdgcn_kernarg_segment_ptr(); asm volatile("" : "+s"(A));
        unsigned char* ws = A->ws; float* hres = A->out;
        int lane, wave = wave0, bx = blockIdx.x;
        asm volatile("v_mbcnt_lo_u32_b32 %0, -1, 0\n\tv_mbcnt_hi_u32_b32 %0, -1, %0" : "=v"(lane)); asm volatile("" : "+s"(wave)); asm volatile("" : "+s"(bx));
        const int tid = wave * 64 + lane;
        const int G = gridDim.x, vcu = (G % 8 == 0) ? (bx % 8) * (G / 8) + bx / 8 : bx;
        const int gw = vcu * 8 + wave, NGW = G * 8, gtid = bx * 512 + tid, NT = G * 512;
        if (ph == 0) { if constexpr ((PHMASK >> 11) & 1) phase_convert(A, lds, gw, NGW, wave, lane, gtid, NT); }
        else if (ph == NPH - 1) { phase_norm<2>(hres, A->in[21], nullptr, hres, gw, NGW, lane); }
        else {
            const int l = (ph - 1) / NSUB, sub = (ph - 1) % NSUB;
            const bf16_t* WL = (const bf16_t*)(ws + WS_W + (size_t)l * W_LAYER_STRIDE);
            switch (sub) {
            case 0: if constexpr ((PHMASK >> 0) & 1) {
                for (int it = bx; it < 256; it += G) s5_tables(A, l, it >> 3, it & 7, lds, tid);
                if (l == 0) phase_norm<1>(A->in[0], A->in[1], XN, hres, gw, NGW, lane); else phase_norm<0>(hres, A->in[1] + (size_t)l * DM, XN, nullptr, gw, NGW, lane);
            } break;
            case 1: if constexpr ((PHMASK >> 1) & 1) {
                { SchedIn S{G, bx, CP(XN), CP(WL + W_IN)}; run_gemm(lds, S, 1024, 1024, 1024, FG1{AS5, UPOOL, Qb, Kb}); }
                { SchedVt S{G, bx, CP(WL + W_IN + (size_t)3072 * 1024), CP(XN)}; run_gemm(lds, S, 1024, 1024, 16 * 1024, FVt{VT}); }
            } break;
            case 2: if constexpr ((PHMASK >> 2) & 1) {
                { SchedS1 S{G, bx, CP(AS5), CP(W1t)}; run_gemm(lds, S, 512, AS5_PITCH, 512, FS1{SST}); }
                phase_attn(Qb, Kb, VT, Qb, vcu, G, wave, lane);
            } break;
            case 3: if constexpr ((PHMASK >> 3) & 1) {
                if (wave < 2) { for (int w = bx * 2 + wave; w < 512; w += G * 2) s5_scan(A, l, w, lane); }
                phase_pool(UPOOL, POOLED, gw, NGW, lane);
            } break;
            case 4: if constexpr ((PHMASK >> 4) & 1) {
                SchedS3 S{G, bx, CP(AS5), CP(Tt)}; run_gemm(lds, S, AS5_PITCH, AS5_PITCH, AS5_PITCH, FS3{Yb});
            } break;
            case 5: if constexpr ((PHMASK >> 5) & 1) {
                SchedGlu S{G, bx, CP(Yb), CP(WL + W_GLU)}; run_gemm(lds, S, 512, 512, 512, FGlu{Yb, YS5});
            } break;
            case 6: {
                { Sched1k S{G, bx, CP(XN), CP(WL + W_IN + (size_t)4096 * 1024)}; run_gemm(lds, S, 1024, 1024, 1024, FGate{GT}); }
                { Sched512 S{G, bx, CP(YS5), CP(WL + W_BS)}; run_gemm(lds, S, 512, 512, 512, FBranch<0>{GT, MERGED}); }
                { Sched1k S{G, bx, CP(XN), CP(WL + W_IN + (size_t)5120 * 1024)}; run_gemm(lds, S, 1024, 1024, 1024, FGate{GT}); }
                { Sched512 S{G, bx, CP(POOLED), CP(WL + W_BP)}; run_gemm(lds, S, 512, 512, 512, FBranch<1>{GT, MERGED}); }
                { Sched1k S{G, bx, CP(XN), CP(WL + W_IN + (size_t)6144 * 1024)}; run_gemm(lds, S, 1024, 1024, 1024, FGate{GT}); }
                { Sched1k S{G, bx, CP(Qb), CP(WL + W_BA)}; run_gemm(lds, S, 1024, 1024, 1024, FBranch<2>{GT, MERGED}); }
            } break;
            case 7: { Sched1k S{G, bx, CP(MERGED), CP(WL + W_OUT)}; run_gemm(lds, S, 1024, 1024, 1024, FResid{hres}); } break;
            case 8: { phase_norm<0>(hres, A->in[18] + (size_t)l * DM, XN, nullptr, gw, NGW, lane); } break;
            case 9: { SchedUp S{G, bx, CP(XN), CP(WL + W_UP)}; run_gemm(lds, S, 1024, 1024, 1024, FUp{HID}); } break;
            case 10: { SchedDn S{G, bx, CP(HID), CP(WL + W_DN)}; run_gemm(lds, S, 4096, 4096, 4096, FResid{hres}); } break;
            }
        }
        if (ph + 1 < ph_hi && ph != 0) {
            if (ph_hi < 0) { __threadfence(); cg::this_grid().sync(); }
            { XcdBarrier xb; xb.bar = (unsigned*)A->ws; xb.x = xb_xcc_id(); xb.st = bst; xcd_barrier(xb); }
        }
    }
}

#ifndef LAST_PH
#define LAST_PH (NPH - 1)
#endif
#ifdef DUMP_OFF
__global__ void dump_kernel(const unsigned short* src, float* dst, size_t n) { for (size_t i = (size_t)blockIdx.x * blockDim.x + threadIdx.x; i < n; i += (size_t)gridDim.x * blockDim.x) dst[i] = __uint_as_float((unsigned)src[i] << 16); }
#endif
extern "C" void kernel_launch(void* const* d_in, const int* in_sizes, int n_in, void* d_out, int out_size, void* d_ws, size_t ws_size, hipStream_t stream) {
    static int grid = 0;
    if (grid == 0) {
        if (n_in != 22 || out_size != MTOK * DM || ws_size < WS_END) { fprintf(stderr, "kernel_launch: unexpected shapes (n_in %d, out %d, ws %zu < %zu)\n", n_in, out_size, ws_size, (size_t)WS_END); grid = -1; return; }
        int dev = 0, cus = 0, per_cu = 0;
        hipGetDevice(&dev); hipDeviceGetAttribute(&cus, hipDeviceAttributeMultiprocessorCount, dev);
        if (hipFuncSetAttribute((const void*)fwd_kernel, hipFuncAttributeMaxDynamicSharedMemorySize, LDS_BYTES) != hipSuccess) { fprintf(stderr, "kernel_launch: hipFuncSetAttribute failed\n"); grid = -1; return; }
        hipOccupancyMaxActiveBlocksPerMultiprocessor(&per_cu, (const void*)fwd_kernel, 512, LDS_BYTES);
        (void)hipGetLastError();
        if (per_cu < 1) fprintf(stderr, "kernel_launch: occupancy query says %d blocks per CU\n", per_cu);
        grid = cus;
        if (grid != 256) fprintf(stderr, "kernel_launch: %d CUs (tuned for 256)\n", grid);
        while ((NB * 16 * 256) % grid != 0 || grid % 8 != 0) --grid;
    }
    if (grid < 0) return;
    (void)hipMemsetAsync(d_ws, 0, 65536, stream);
    Args a{};
    for (int i = 0; i < 22; ++i) a.in[i] = (const float*)d_in[i];
    a.out = (float*)d_out; a.ws = (unsigned char*)d_ws;
#if ONE_LAUNCH
    a.ph_lo = 0; a.ph_hi = NPH;
    void* args[] = {&a};
    hipError_t e = hipLaunchCooperativeKernel((const void*)fwd_kernel, dim3(grid), dim3(512), args, LDS_BYTES, stream);
    if (e != hipSuccess) fprintf(stderr, "cooperative launch failed: %s (grid %d)\n", hipGetErrorString(e), grid);
#else
    for (int ph = 0; ph <= LAST_PH; ++ph) { a.ph_lo = ph; a.ph_hi = ph + 1; hipLaunchKernelGGL(fwd_kernel, dim3(grid), dim3(512), LDS_BYTES, stream, a); }
#ifdef DUMP_OFF
    hipLaunchKernelGGL(dump_kernel, dim3(2048), dim3(256), 0, stream, (const unsigned short*)((const char*)d_ws + (size_t)(DUMP_OFF)), (float*)d_out, (size_t)MTOK * DM);
#endif
#endif
}
```

```cpp
#include <hip/hip_runtime.h>
#include <hip/hip_cooperative_groups.h>
#include <cstdio>
#include <cstdint>
namespace cg = cooperative_groups;

#ifndef ONE_LAUNCH
#define ONE_LAUNCH 1
#endif

#define LAS __attribute__((address_space(3)))
#define PG8_LAS __attribute__((address_space(3)))
typedef unsigned short bf16_t;
typedef short bf16x8 __attribute__((ext_vector_type(8)));
typedef float f32x4 __attribute__((ext_vector_type(4)));
typedef float f32x2 __attribute__((ext_vector_type(2)));
typedef unsigned u32x4 __attribute__((ext_vector_type(4)));
typedef unsigned u32x2 __attribute__((ext_vector_type(2)));

constexpr int NB = 8, SEQ = 4096, DM = 1024, MTOK = NB * SEQ, DFF = 4096, NLAYER = 2;
constexpr float NORM_EPS = 1e-6f;
constexpr float LOG2E = 1.4426950408889634f;
constexpr float QSCALE = 0.125f * LOG2E;
constexpr int LC = 32;
constexpr int AS5_PITCH = 768;

constexpr size_t MiB = (size_t)1 << 20;
constexpr size_t WS_W = 1 * MiB, W_LAYER_STRIDE = 37 * MiB;
constexpr size_t W_IN = 0, W_GLU = 7340032, W_BS = 7602176, W_BP = 8126464, W_BA = 8650752, W_OUT = 9699328, W_UP = 10747904, W_DN = 14942208;
constexpr size_t WS_T = 75 * MiB, WS_W1 = 99 * MiB, WS_XN = 107 * MiB, WS_UPOOL = 171 * MiB, WS_AS5 = 203 * MiB, WS_Q = 251 * MiB, WS_K = 315 * MiB, WS_VT = 379 * MiB,
                 WS_SST = 443 * MiB, WS_END = 475 * MiB;
constexpr size_t WS_POOLED = WS_K, WS_YS5 = WS_K + 32 * MiB, WS_GT = WS_VT, WS_MERGED = WS_UPOOL, WS_Y = WS_SST, WS_HID = WS_UPOOL;
constexpr int LDS_BYTES = 135168;

struct Args { const float* in[22]; float* out; unsigned char* ws; int ph_lo, ph_hi; };
typedef const __attribute__((address_space(4))) Args* KArgP;

typedef __bf16 bf16x2_t __attribute__((ext_vector_type(2)));
__device__ __forceinline__ unsigned cvt_pk_bf16(float lo, float hi) { const f32x2 v = {lo, hi}; const bf16x2_t b = __builtin_convertvector(v, bf16x2_t); return __builtin_bit_cast(unsigned, b); }
__device__ __forceinline__ u32x4 pack8(f32x4 a, f32x4 b) { u32x4 w; w.x = cvt_pk_bf16(a[0], a[1]); w.y = cvt_pk_bf16(a[2], a[3]); w.z = cvt_pk_bf16(b[0], b[1]); w.w = cvt_pk_bf16(b[2], b[3]); return w; }
__device__ __forceinline__ float bf_lo(unsigned w) { return __uint_as_float(w << 16); }
__device__ __forceinline__ float bf_hi(unsigned w) { return __uint_as_float(w & 0xffff0000u); }
__device__ __forceinline__ void unpack8(u32x4 w, f32x4& a, f32x4& b) { a = (f32x4){bf_lo(w.x), bf_hi(w.x), bf_lo(w.y), bf_hi(w.y)}; b = (f32x4){bf_lo(w.z), bf_hi(w.z), bf_lo(w.w), bf_hi(w.w)}; }
__device__ __forceinline__ float fast_sigmoid(float x) { return __builtin_amdgcn_rcpf(1.0f + __builtin_amdgcn_exp2f(-LOG2E * x)); }
__device__ __forceinline__ f32x4 sig4(f32x4 v) { return (f32x4){fast_sigmoid(v[0]), fast_sigmoid(v[1]), fast_sigmoid(v[2]), fast_sigmoid(v[3])}; }
__device__ __forceinline__ float gelu_tanh(float y) { const float u = 0.7978845608028654f * (y + 0.044715f * y * y * y); return y * fast_sigmoid(2.0f * u); }
__device__ __forceinline__ f32x4 gelu4(f32x4 v) { return (f32x4){gelu_tanh(v[0]), gelu_tanh(v[1]), gelu_tanh(v[2]), gelu_tanh(v[3])}; }
__device__ __forceinline__ float shx(float v, int o, int lane) { return __int_as_float(__builtin_amdgcn_ds_bpermute((lane ^ o) << 2, __float_as_int(v))); }
__device__ __forceinline__ float wave_sum(float v, int lane) {
#pragma unroll
    for (int o = 1; o < 64; o <<= 1) v += shx(v, o, lane);
    return v;
}

namespace pg8 {
constexpr int BM = 256, BK = 64, HALF = 128, HTB = HALF * BK * 2, STAGE_BYTES = 8 * HTB, NXCD = 8, WGM = 8;
__host__ __device__ __forceinline__ int lds_byte(int r, int c) { const int st = (r >> 4) * 2 + (c >> 5), rr = r & 15, cc = c & 31, ob = rr * 64 + cc * 2; return st * 1024 + (ob ^ (((ob >> 9) & 1) << 5)); }
__host__ __device__ __forceinline__ void stage_rc(int b, int& R, int& C) { const int st = b / 1024, sb = b % 1024, swz = sb ^ (((sb >> 9) & 1) << 5); R = (st >> 1) * 16 + swz / 64; C = (st & 1) * 32 + (swz % 64) / 2; }
__host__ __device__ __forceinline__ int perm32(int rho) { const int n = rho >> 4, i = rho & 15; return 8 * (i >> 2) + 4 * n + (i & 3); }

struct Unit { int pm, pn; const char* a; const char* b; };
struct Gemm { int K, lda, ldb; };

template <int NM, int NN, int NMZ, int BDIV, unsigned AZ, unsigned AT, unsigned BZ, unsigned BLO, unsigned BHI>
struct SchedT {
    int G, c; const char* A; const char* B;
    __device__ __forceinline__ bool next(int i, Unit& u) const {
        constexpr int nwg = NM * NN;
        const int L = i * G + c; if (L >= nwg) return false;
        int wgid = L; { constexpr int q = nwg / NXCD, r = nwg % NXCD; const int xcd = wgid % NXCD, off = wgid / NXCD; wgid = (xcd < r ? xcd * (q + 1) : r * (q + 1) + (xcd - r) * q) + off; }
        constexpr int nig = WGM * NN; const int gid = wgid / nig, fm = gid * WGM, gsz = (NM - fm) < WGM ? (NM - fm) : WGM;
        u.pm = fm + ((wgid % nig) % gsz); u.pn = (wgid % nig) / gsz;
        const int z = u.pm / NMZ, pmz = u.pm - z * NMZ;
        u.a = A + (size_t)z * AZ + (size_t)pmz * AT;
        u.b = B + (size_t)z * BZ + (size_t)(u.pn / BDIV) * BHI + (size_t)(u.pn % BDIV) * BLO;
        return true;
    }
    __device__ __forceinline__ void a_ready(const Unit&) const {}
    __device__ __forceinline__ void done(const Unit&) const {}
};

struct EpiBuf { u32x4 a, b; };
template <class F> struct EpiT {
    static constexpr bool PERM = true, AFTER_DRAIN = false; F f;
    __device__ __forceinline__ void operator()(const f32x4 (&acc)[2][2][4][2], const Unit& u, int wr, int wc, int fr, int fq) const {
#pragma unroll
        for (int ai = 0; ai < 2; ++ai) {
            EpiBuf buf[4][2];
            if constexpr (F::NLOAD > 0) {
#pragma unroll
                for (int m = 0; m < 4; ++m)
#pragma unroll
                    for (int bj = 0; bj < 2; ++bj) f.load(u.pm * BM + ai * HALF + wr * 64 + m * 16 + fr, u.pn * BM + bj * HALF + wc * 32 + 8 * fq, buf[m][bj]);
            }
#pragma unroll
            for (int m = 0; m < 4; ++m)
#pragma unroll
                for (int bj = 0; bj < 2; ++bj) f.apply(u.pm * BM + ai * HALF + wr * 64 + m * 16 + fr, u.pn * BM + bj * HALF + wc * 32 + 8 * fq, acc[ai][bj][m][0], acc[ai][bj][m][1], buf[m][bj]);
            asm volatile("" ::: "memory");
        }
    }
    __device__ __forceinline__ void fused(f32x4 (&)[2][2][4][2], const Unit&, int, int, int, int, PG8_LAS unsigned char*, int, int) const {}
};

template <class Epi, class Sched, bool ALIGN_EPI = false, bool SP2 = false>
__device__ __forceinline__ void gemm_phase(PG8_LAS unsigned char* lds, const Gemm g, const Sched& S, const Epi& E, const int tid) {
    const int  wid = __builtin_amdgcn_readfirstlane(tid >> 6), lane = tid & 63, wr = wid >> 2, wc = wid & 3, fr = lane & 15, fq = lane >> 4;
    const int K = g.K, nt = K / BK;
    unsigned voffA[2], voffB[2];
#pragma unroll
    for (int i = 0; i < 2; ++i) { int R, C; stage_rc(tid * 16 + i * 8192, R, C); const int Rb = Epi::PERM ? ((R & ~31) + perm32(R & 31)) : R;
        voffA[i] = (unsigned)(R * g.lda + C) * 2u; voffB[i] = (unsigned)(Rb * g.ldb + C) * 2u; }
    const size_t kstep = (size_t)(BK * 2);
    const size_t hstepA = (size_t)HALF * g.lda * 2, hstepB = (size_t)HALF * g.ldb * 2;
    const unsigned ldsw = (unsigned)wid * 1024u;
    const int aoff = lds_byte(wr * 64 + fr, fq * 8), boff = lds_byte(wc * 32 + fr, fq * 8);
#define PG8_SA(b, h) (((b) * 2 + (h)) * HTB)
#define PG8_SB(b, h) ((4 + (b) * 2 + (h)) * HTB)
#define PG8_STAGE(bufoff, gbase, voff) do { _Pragma("unroll") for (int _i = 0; _i < 2; ++_i) \
        __builtin_amdgcn_global_load_lds((const unsigned*)((const char*)(gbase) + (voff)[_i]), (PG8_LAS unsigned*)(lds + (bufoff) + ldsw + _i * 8192), 16, 0, 0); } while (0)
#define PG8_LDA(dst, b, h) do { _Pragma("unroll") for (int m = 0; m < 4; ++m) _Pragma("unroll") for (int k = 0; k < 2; ++k) dst[m][k] = *(const PG8_LAS bf16x8*)(lds + PG8_SA(b, h) + aoff + m * 2048 + k * 1024); } while (0)
#define PG8_LDB(dst, b, h) do { _Pragma("unroll") for (int n = 0; n < 2; ++n) _Pragma("unroll") for (int k = 0; k < 2; ++k) dst[n][k] = *(const PG8_LAS bf16x8*)(lds + PG8_SB(b, h) + boff + n * 2048 + k * 1024); } while (0)
#define PG8_MMA(ai, bj, At, Bt) do { __builtin_amdgcn_s_setprio(1); _Pragma("unroll") for (int m = 0; m < 4; ++m) _Pragma("unroll") for (int n = 0; n < 2; ++n) _Pragma("unroll") for (int k = 0; k < 2; ++k) \
        acc[ai][bj][m][n] = __builtin_amdgcn_mfma_f32_16x16x32_bf16(Bt[n][k], At[m][k], acc[ai][bj][m][n], 0, 0, 0); __builtin_amdgcn_s_setprio(0); } while (0)
#define PG8_WAIT_V(n) asm volatile("s_waitcnt vmcnt(" #n ")" ::: "memory")
#define PG8_WAIT_L(n) asm volatile("s_waitcnt lgkmcnt(" #n ")" ::: "memory")
#define PG8_BAR __builtin_amdgcn_s_barrier()
#define PG8_SCHED __builtin_amdgcn_sched_barrier(0)
    Unit cur, nxt; int ui = 0;
    if (!S.next(0, cur)) return;
    f32x4 acc[2][2][4][2];
#pragma unroll
    for (int a = 0; a < 2; ++a)
#pragma unroll
        for (int b = 0; b < 2; ++b)
#pragma unroll
            for (int m = 0; m < 4; ++m)
#pragma unroll
                for (int n = 0; n < 2; ++n) acc[a][b][m][n] = (f32x4){0.f, 0.f, 0.f, 0.f};
    bf16x8 At[4][2], B0[2][2], B1[2][2];
    const char* cA = cur.a; const char* cB = cur.b;
    S.a_ready(cur);
    if constexpr (SP2) {
        PG8_STAGE(PG8_SB(0, 0), cB, voffB); PG8_STAGE(PG8_SB(0, 1), cB + hstepB, voffB); PG8_STAGE(PG8_SA(0, 0), cA, voffA); PG8_STAGE(PG8_SA(0, 1), cA + hstepA, voffA);
        if (wr == 1) PG8_BAR;
        PG8_WAIT_V(2); PG8_BAR;
        PG8_STAGE(PG8_SB(1, 0), cB + kstep, voffB); PG8_STAGE(PG8_SA(1, 0), cA + kstep, voffA); PG8_STAGE(PG8_SB(1, 1), cB + hstepB + kstep, voffB);
        PG8_WAIT_V(6); PG8_BAR;
    } else {
        PG8_STAGE(PG8_SB(0, 0), cB, voffB); PG8_STAGE(PG8_SA(0, 0), cA, voffA); PG8_STAGE(PG8_SB(0, 1), cB + hstepB, voffB); PG8_STAGE(PG8_SA(0, 1), cA + hstepA, voffA);
        if (wr == 1) PG8_BAR;
        PG8_WAIT_V(4); PG8_BAR;
        PG8_STAGE(PG8_SB(1, 0), cB + kstep, voffB); PG8_STAGE(PG8_SA(1, 0), cA + kstep, voffA); PG8_STAGE(PG8_SB(1, 1), cB + hstepB + kstep, voffB);
        PG8_WAIT_V(6); PG8_BAR;
    }
    for (;;) {
        const bool has_next = S.next(ui + 1, nxt);
        const char* nA = has_next ? nxt.a : cA; const char* nB = has_next ? nxt.b : cB;
        for (int t = 0; t < nt; t += 2) {
            const bool last = (t == nt - 2);
            const char* a1 = cA + (size_t)(t + 1) * kstep;
            const char* a2 = last ? nA : cA + (size_t)(t + 2) * kstep; const char* b2 = last ? nB : cB + (size_t)(t + 2) * kstep;
            const char* a3 = a2 + kstep; const char* b3 = b2 + kstep;
            if (last && has_next) S.a_ready(nxt);
            if constexpr (SP2) {
            PG8_LDB(B0, 0, 0); PG8_LDB(B1, 0, 1); PG8_SCHED; PG8_LDA(At, 0, 0); PG8_STAGE(PG8_SA(1, 1), a1 + hstepA, voffA);
            PG8_WAIT_V(8); PG8_WAIT_L(0); PG8_BAR; PG8_MMA(0, 0, At, B0); PG8_MMA(0, 1, At, B1); PG8_BAR; PG8_SCHED;
            PG8_LDA(At, 0, 1); PG8_STAGE(PG8_SB(0, 0), b2, voffB); PG8_STAGE(PG8_SB(0, 1), b2 + hstepB, voffB); PG8_STAGE(PG8_SA(0, 0), a2, voffA);
            PG8_WAIT_V(8); PG8_WAIT_L(0); PG8_BAR; PG8_MMA(1, 0, At, B0); PG8_MMA(1, 1, At, B1); PG8_BAR; PG8_SCHED;
            PG8_LDB(B0, 1, 0); PG8_LDB(B1, 1, 1); PG8_SCHED; PG8_LDA(At, 1, 0); PG8_STAGE(PG8_SA(0, 1), a2 + hstepA, voffA);
            PG8_WAIT_V(8); PG8_WAIT_L(0); PG8_BAR; PG8_MMA(0, 0, At, B0); PG8_MMA(0, 1, At, B1); PG8_BAR; PG8_SCHED;
            PG8_LDA(At, 1, 1); PG8_STAGE(PG8_SB(1, 0), b3, voffB); PG8_STAGE(PG8_SB(1, 1), b3 + hstepB, voffB); PG8_STAGE(PG8_SA(1, 0), a3, voffA);
            PG8_WAIT_V(8); PG8_WAIT_L(0); PG8_BAR; PG8_MMA(1, 0, At, B0); PG8_MMA(1, 1, At, B1); PG8_BAR; PG8_SCHED;
            } else {
            PG8_LDB(B0, 0, 0); PG8_SCHED; PG8_LDA(At, 0, 0); PG8_STAGE(PG8_SA(1, 1), a1 + hstepA, voffA);
            PG8_WAIT_L(8); PG8_BAR; PG8_WAIT_L(0); PG8_MMA(0, 0, At, B0); PG8_BAR; PG8_SCHED;
            PG8_LDB(B1, 0, 1); PG8_STAGE(PG8_SB(0, 0), b2, voffB);
            PG8_BAR; PG8_WAIT_L(0); PG8_MMA(0, 1, At, B1); PG8_BAR;
            PG8_LDA(At, 0, 1); PG8_STAGE(PG8_SA(0, 0), a2, voffA);
            PG8_BAR; PG8_WAIT_L(0); PG8_MMA(1, 0, At, B0); PG8_BAR; PG8_SCHED;
            PG8_STAGE(PG8_SB(0, 1), b2 + hstepB, voffB);
            PG8_WAIT_V(6); PG8_BAR; PG8_MMA(1, 1, At, B1); PG8_BAR;
            PG8_LDB(B0, 1, 0); PG8_SCHED; PG8_LDA(At, 1, 0); PG8_STAGE(PG8_SA(0, 1), a2 + hstepA, voffA);
            PG8_WAIT_L(8); PG8_BAR; PG8_WAIT_L(0); PG8_MMA(0, 0, At, B0); PG8_BAR; PG8_SCHED;
            PG8_LDB(B1, 1, 1); PG8_STAGE(PG8_SB(1, 0), b3, voffB);
            PG8_BAR; PG8_WAIT_L(0); PG8_MMA(0, 1, At, B1); PG8_BAR;
            PG8_LDA(At, 1, 1); PG8_STAGE(PG8_SA(1, 0), a3, voffA);
            PG8_BAR; PG8_WAIT_L(0); PG8_MMA(1, 0, At, B0); PG8_BAR; PG8_SCHED;
            PG8_STAGE(PG8_SB(1, 1), b3 + hstepB, voffB);
            PG8_WAIT_V(6); PG8_BAR; PG8_MMA(1, 1, At, B1); PG8_BAR;
            }
        }
        if constexpr (ALIGN_EPI) { if (wr == 0) PG8_BAR; }
        if constexpr (!Epi::AFTER_DRAIN) { E(acc, cur, wr, wc, fr, fq); S.done(cur); }
        if (!has_next) break;
#pragma unroll
        for (int a = 0; a < 2; ++a)
#pragma unroll
            for (int b = 0; b < 2; ++b)
#pragma unroll
                for (int m = 0; m < 4; ++m)
#pragma unroll
                    for (int n = 0; n < 2; ++n) acc[a][b][m][n] = (f32x4){0.f, 0.f, 0.f, 0.f};
        cur = nxt; cA = nA; cB = nB; ++ui;
        if constexpr (ALIGN_EPI) { if (wr == 1) PG8_BAR; }
    }
    PG8_WAIT_V(0);
    if constexpr (!ALIGN_EPI) { if (wr == 0) PG8_BAR; }
    PG8_BAR;
    if constexpr (Epi::AFTER_DRAIN) { E.fused(acc, cur, wr, wc, fr, fq, lds, wid, lane); S.done(cur); }
#undef PG8_SA
#undef PG8_SB
#undef PG8_STAGE
#undef PG8_LDA
#undef PG8_LDB
#undef PG8_MMA
#undef PG8_WAIT_V
#undef PG8_WAIT_L
#undef PG8_BAR
#undef PG8_SCHED
}
}

struct FG1 { static constexpr int NLOAD = 0;
    bf16_t *as5, *upool, *q, *k;
    __device__ __forceinline__ void apply(int row, int col, f32x4 a, f32x4 b, const pg8::EpiBuf& lb) const {
        if (col < 512) { const int g = col >> 4, q0 = col & 15, bb = row >> 12, t = row & 4095, c = t >> 5, i = t & 31;
            *(u32x4*)(as5 + ((size_t)(g * 1024 + bb * 128 + c) * AS5_PITCH + i * 16 + q0)) = pack8(a, b); }
        else if (col < 1024) *(u32x4*)(upool + (size_t)row * 512 + (col - 512)) = pack8(a, b);
        else if (col < 2048) *(u32x4*)(q + (size_t)row * 1024 + (col - 1024)) = pack8(a * QSCALE, b * QSCALE);
        else { const int hd = col - 2048, h = hd >> 6, d0 = hd & 63, bb = row >> 12, t = row & 4095;
            *(u32x4*)(k + ((size_t)(((bb * 16 + h) * 16 + (t & 15)) * 256 + (t >> 4)) * 64 + d0)) = pack8(a, b); }
    }
};
struct FPlain { static constexpr int NLOAD = 0; bf16_t* o; int ldc; __device__ __forceinline__ void apply(int row, int col, f32x4 a, f32x4 b, const pg8::EpiBuf& lb) const { *(u32x4*)(o + (size_t)row * ldc + col) = pack8(a, b); } };
struct FVt { static constexpr int NLOAD = 0;
    bf16_t* v;
    __device__ __forceinline__ void apply(int row, int col, f32x4 a, f32x4 b, const pg8::EpiBuf& lb) const {
        const int h = row >> 6, d = row & 63, bb = col >> 12, rho = (col >> 8) & 15, i = col & 255;
        bf16_t* p = v + ((size_t)((((bb * 16 + h) * 16 + rho) * 64 + (i >> 2)) * 64 + d)) * 4;
        u32x2 w0, w1; w0.x = cvt_pk_bf16(a[0], a[1]); w0.y = cvt_pk_bf16(a[2], a[3]); w1.x = cvt_pk_bf16(b[0], b[1]); w1.y = cvt_pk_bf16(b[2], b[3]);
        *(u32x2*)p = w0; *(u32x2*)(p + 256) = w1; }
};
struct FS1 { static constexpr int NLOAD = 0; float* s; __device__ __forceinline__ void apply(int row, int col, f32x4 a, f32x4 b, const pg8::EpiBuf& lb) const { f32x4* p = (f32x4*)(s + (size_t)row * 256 + col); p[0] = a; p[1] = b; } };
struct FS3 { static constexpr int NLOAD = 0;
    bf16_t* y;
    __device__ __forceinline__ void apply(int row, int col, f32x4 a, f32x4 b, const pg8::EpiBuf& lb) const {
        const int g = row >> 10, bc = row & 1023, bb = bc >> 7, c = bc & 127, j = col >> 4, p0 = col & 15;
        const size_t tok = (size_t)bb * 4096 + c * 32 + j;
        *(u32x4*)(y + tok * 512 + g * 16 + p0) = pack8(gelu4(a), gelu4(b)); }
};
struct FGlu { static constexpr int NLOAD = 1; const bf16_t* y; bf16_t* o;
    __device__ __forceinline__ void load(int row, int col, pg8::EpiBuf& lb) const { lb.a = *(const u32x4*)(y + (size_t)row * 512 + col); }
    __device__ __forceinline__ void apply(int row, int col, f32x4 a, f32x4 b, const pg8::EpiBuf& lb) const {
        f32x4 ya, yb; unpack8(lb.a, ya, yb);
        *(u32x4*)(o + (size_t)row * 512 + col) = pack8(ya * sig4(a), yb * sig4(b)); }
};
struct FGate { static constexpr int NLOAD = 0; bf16_t* gt; __device__ __forceinline__ void apply(int row, int col, f32x4 a, f32x4 b, const pg8::EpiBuf& lb) const { *(u32x4*)(gt + (size_t)row * 1024 + col) = pack8(sig4(a), sig4(b)); } };
template <int MODE> struct FBranch { static constexpr int NLOAD = 2; const bf16_t* gt; bf16_t* mg;
    __device__ __forceinline__ void load(int row, int col, pg8::EpiBuf& lb) const { const size_t o = (size_t)row * 1024 + col; lb.a = *(const u32x4*)(gt + o); if (MODE) lb.b = *(const u32x4*)(mg + o); }
    __device__ __forceinline__ void apply(int row, int col, f32x4 a, f32x4 b, const pg8::EpiBuf& lb) const {
        const size_t o = (size_t)row * 1024 + col; f32x4 ga, gb; unpack8(lb.a, ga, gb);
        f32x4 va = ga * a, vb = gb * b;
        if (MODE) { f32x4 ma, mb; unpack8(lb.b, ma, mb); va += ma; vb += mb; }
        *(u32x4*)(mg + o) = pack8(va, vb); }
};
struct FResid { static constexpr int NLOAD = 2; float* h;
    __device__ __forceinline__ void load(int row, int col, pg8::EpiBuf& lb) const { const u32x4* p = (const u32x4*)(h + (size_t)row * 1024 + col); lb.a = p[0]; lb.b = p[1]; }
    __device__ __forceinline__ void apply(int row, int col, f32x4 a, f32x4 b, const pg8::EpiBuf& lb) const {
        f32x4* p = (f32x4*)(h + (size_t)row * 1024 + col); p[0] = __builtin_bit_cast(f32x4, lb.a) + a; p[1] = __builtin_bit_cast(f32x4, lb.b) + b; }
};
struct FUp { static constexpr int NLOAD = 0; bf16_t* hid;
    __device__ __forceinline__ void apply(int row, int col, f32x4 a, f32x4 b, const pg8::EpiBuf& lb) const {
        f32x4 ra, rb;
#pragma unroll
        for (int i = 0; i < 4; ++i) { const float x = fmaxf(a[i], 0.f), y = fmaxf(b[i], 0.f); ra[i] = x * x; rb[i] = y * y; }
        *(u32x4*)(hid + (size_t)row * 4096 + col) = pack8(ra, rb); }
};

template <class SC, class F> __device__ __forceinline__ void run_gemm_(LAS unsigned char* lds, const SC& S, int K, int lda, int ldb, const F& f, int tid) {
    __builtin_amdgcn_fence(__ATOMIC_ACQUIRE, "agent");
    asm volatile("" : "+v"(tid));
    pg8::Gemm g{K, lda, ldb}; pg8::EpiT<F> E{f};
    pg8::gemm_phase<pg8::EpiT<F>, SC, true, true>(lds, g, S, E, tid);
}

__device__ __forceinline__ unsigned f2bf(float f) { unsigned u = __builtin_bit_cast(unsigned, f); return (u + 0x7fffu + ((u >> 16) & 1u)) >> 16; }
__device__ __forceinline__ unsigned pk2(float lo, float hi) { return f2bf(lo) | (f2bf(hi) << 16); }
__device__ __forceinline__ void transpose_item(const float* W, int K, int N, bf16_t* WT, LAS float* scr, int item, int lane) {
    const int nblk = N / 32, kb = item / nblk, nb = item % nblk, k0 = 64 * kb, n0 = 32 * nb;
    float wv[32];
#pragma unroll
    for (int i = 0; i < 32; ++i) wv[i] = W[(size_t)(k0 + 2 * i + (lane >> 5)) * N + n0 + (lane & 31)];
#pragma unroll
    for (int i = 0; i < 32; ++i) scr[(2 * i + (lane >> 5)) * 33 + (lane & 31)] = wv[i];
    asm volatile("s_waitcnt lgkmcnt(0)" ::: "memory");
    const int c = lane & 7;
#pragma unroll
    for (int j = 0; j < 4; ++j) { const int n = (lane >> 3) + 8 * j; const LAS float* s = scr + (8 * c) * 33 + n;
        u32x4 o; o.x = pk2(s[0 * 33], s[1 * 33]); o.y = pk2(s[2 * 33], s[3 * 33]); o.z = pk2(s[4 * 33], s[5 * 33]); o.w = pk2(s[6 * 33], s[7 * 33]);
        *(u32x4*)(WT + (size_t)(n0 + n) * K + k0 + 8 * c) = o; }
    asm volatile("s_waitcnt lgkmcnt(0)" ::: "memory");
}
__device__ __forceinline__ void phase_convert(KArgP A, LAS unsigned char* lds, int gw, int NGW, int wave, int lane, int gtid, int NT) {
    LAS float* scr = (LAS float*)(lds + wave * 16384);
    for (int l = 0; l < NLAYER; ++l) {
        bf16_t* WL = (bf16_t*)(A->ws + WS_W + (size_t)l * W_LAYER_STRIDE);
        const float* srcs[7] = {A->in[2] + (size_t)l * 1024 * 7168, A->in[11] + (size_t)l * 512 * 512, A->in[14] + (size_t)l * 512 * 1024, A->in[16] + (size_t)l * 1024 * 1024,
                                A->in[17] + (size_t)l * 1024 * 1024, A->in[19] + (size_t)l * 1024 * 4096, A->in[20] + (size_t)l * 4096 * 1024};
        const int Ks[7] = {1024, 512, 512, 1024, 1024, 1024, 4096}, Ns[7] = {7168, 512, 1024, 1024, 1024, 4096, 1024};
        const size_t offs[7] = {W_IN, W_GLU, W_BS, W_BA, W_OUT, W_UP, W_DN};
#pragma unroll
        for (int w = 0; w < 7; ++w) { const int items = (Ks[w] / 64) * (Ns[w] / 32);
            for (int it = gw; it < items; it += NGW) transpose_item(srcs[w], Ks[w], Ns[w], WL + offs[w], scr, it, lane); }
        const float* pw = A->in[12] + (size_t)l * 4 * 128 * 128; const float* psc = A->in[13] + (size_t)l * 512; const float* wbp = A->in[15] + (size_t)l * 512 * 1024;
        bf16_t* WP = WL + W_BP;
        for (int e = gtid; e < 1024 * 512; e += NT) { const int k = __builtin_amdgcn_readfirstlane(e >> 10), n = e & 1023, g = k >> 7;
            const float* pr = pw + (size_t)k * 128; const float* sc = psc + g * 128; const float* wb = wbp + (size_t)(g * 128) * 1024 + n; float acc = 0.f;
#pragma unroll 8
            for (int d = 0; d < 128; ++d) acc += (pr[d] * sc[d]) * wb[(size_t)d * 1024];
            WP[(size_t)n * 512 + k] = (bf16_t)f2bf(acc); }
    }
}

template <int MODE  >
__device__ __forceinline__ void phase_norm(const float* src, const float* gain, bf16_t* xn, float* dst, int gw, int NGW, int lane) {
    f32x4 gv[4];
#pragma unroll
    for (int j = 0; j < 4; ++j) gv[j] = *((const f32x4*)gain + lane + 64 * j);
    for (int m = gw; m < MTOK; m += NGW) {
        const f32x4* xr = (const f32x4*)(src + (size_t)m * DM) + lane; f32x4 v[4]; float s = 0.f;
#pragma unroll
        for (int j = 0; j < 4; ++j) { v[j] = xr[64 * j]; s += (v[j].x * v[j].x + v[j].y * v[j].y) + (v[j].z * v[j].z + v[j].w * v[j].w); }
        const float r = 1.0f / sqrtf(wave_sum(s, lane) * (1.0f / DM) + NORM_EPS);
        if (MODE == 1) { f32x4* o = (f32x4*)(dst + (size_t)m * DM) + lane;
#pragma unroll
            for (int j = 0; j < 4; ++j) o[64 * j] = v[j]; }
        if (MODE == 2) { f32x4* o = (f32x4*)(dst + (size_t)m * DM) + lane;
#pragma unroll
            for (int j = 0; j < 4; ++j) o[64 * j] = v[j] * r * gv[j]; }
        else { u32x2* o = (u32x2*)(xn + (size_t)m * DM) + lane;
#pragma unroll
            for (int j = 0; j < 4; ++j) { const f32x4 y = v[j] * r * gv[j]; u32x2 w; w.x = cvt_pk_bf16(y.x, y.y); w.y = cvt_pk_bf16(y.z, y.w); o[64 * j] = w; } }
    }
}

__device__ __forceinline__ void sincos_d(double ang, double& s, double& c) {
    const double x = ang * 0.63661977236758134308; const double q = rint(x); const float y = (float)((x - q) * 1.57079632679489661923); const float y2 = y * y;
    const float sp = y * (1.0f + y2 * (-1.0f / 6 + y2 * (1.0f / 120 + y2 * (-1.0f / 5040 + y2 * (1.0f / 362880)))));
    const float cp = 1.0f + y2 * (-0.5f + y2 * (1.0f / 24 + y2 * (-1.0f / 720 + y2 * (1.0f / 40320 + y2 * (-1.0f / 3628800)))));
    const int qi = ((int)q) & 3;
    s = (double)((qi == 0) ? sp : (qi == 1) ? cp : (qi == 2) ? -sp : -cp);
    c = (double)((qi == 0) ? cp : (qi == 1) ? -sp : (qi == 2) ? -cp : sp);
}
__device__ __forceinline__ void a_pow(float lr, float li, float dt, int d, float& re, float& im) {
    const float mag = expf(lr * dt * (float)d); double s, c; sincos_d((double)li * (double)dt * (double)d, s, c); re = mag * (float)c; im = mag * (float)s;
}
__device__ __forceinline__ void s5_tables(KArgP A, int l, int g, int ps, LAS unsigned char* lds, int tid) {
    LAS f32x2* pw = (LAS f32x2*)lds;
    LAS f32x2* Bb = (LAS f32x2*)(lds + 33792);
    LAS float* Kt = (LAS float*)(lds + 50176);
    const float* lam_re = A->in[3]; const float* lam_im = A->in[4]; const float* log_dt = A->in[5];
    const float* b_re = A->in[6]; const float* b_im = A->in[7]; const float* c_re = A->in[8]; const float* c_im = A->in[9]; const float* dsk = A->in[10];
    for (int e = tid; e < 2 * 33 * 64; e += 512) { const int dir = e / (33 * 64), rem = e - dir * 33 * 64, d = rem >> 6, n = rem & 63; const int gi = (l * 2 + dir) * 32 + g;
        float re, im; a_pow(lam_re[gi * 64 + n], lam_im[gi * 64 + n], expf(log_dt[gi]), d, re, im); pw[e] = (f32x2){re, im}; }
    for (int e = tid; e < 2 * 64 * 16; e += 512) { const int dir = e >> 10, n = (e >> 4) & 63, q = e & 15; const int gi = (l * 2 + dir) * 32 + g;
        const float lr = lam_re[gi * 64 + n], li = lam_im[gi * 64 + n]; float ar, ai; a_pow(lr, li, expf(log_dt[gi]), 1, ar, ai);
        const double nr = (double)ar - 1.0, ni = (double)ai, den = (double)lr * lr + (double)li * li; const double cr = (nr * lr + ni * li) / den, ci = (ni * lr - nr * li) / den;
        const float br = b_re[((size_t)gi * 64 + n) * 16 + q], bi = b_im[((size_t)gi * 64 + n) * 16 + q];
        Bb[e] = (f32x2){(float)(cr * br - ci * bi), (float)(cr * bi + ci * br)}; }
    LAS f32x2* Cc = (LAS f32x2*)(lds + 58368);
    if (tid < 256) { const int dir = tid >> 7, pl = (tid >> 6) & 1, n = tid & 63; const size_t ci_ = ((size_t)((l * 2 + dir) * 32 + g) * 16 + ps * 2 + pl) * 64 + n; Cc[tid] = (f32x2){c_re[ci_], c_im[ci_]}; }
    __syncthreads();
    for (int e = tid; e < 2 * 32 * 2 * 16; e += 512) { const int dir = e >> 10, d = (e >> 5) & 31, pl = (e >> 4) & 1, q = e & 15; float acc = 0.f;
#pragma unroll 8
        for (int n = 0; n < 64; ++n) { const f32x2 w = pw[(dir * 33 + d) * 64 + n], bb = Bb[(dir * 64 + n) * 16 + q], cc = Cc[(dir * 2 + pl) * 64 + n];
            const float zr = w.x * bb.x - w.y * bb.y, zi = w.x * bb.y + w.y * bb.x; acc += cc.x * zr - cc.y * zi; }
        Kt[e] = acc; }
    __syncthreads();
    bf16_t* T = (bf16_t*)(A->ws + WS_T) + (size_t)g * 512 * AS5_PITCH;
    for (int e = tid; e < 64 * 96; e += 512) { const int rr = e / 96, kv = e - rr * 96, j = rr >> 1, pl = rr & 1, p = ps * 2 + pl, k0 = kv * 8; float v[8];
        if (k0 < 512) { const int i = k0 >> 4, q0 = k0 & 15;
#pragma unroll
            for (int t = 0; t < 8; ++t) { const int q = q0 + t; float x = 0.f;
                if (i <= j) x += Kt[((0 * 32 + (j - i)) * 2 + pl) * 16 + q];
                if (i >= j) x += Kt[((1 * 32 + (i - j)) * 2 + pl) * 16 + q];
                if (i == j && q == p) x += dsk[(size_t)l * 512 + g * 16 + p];
                v[t] = x; } }
        else { const int w = (k0 - 512) >> 6, n0 = (k0 - 512) & 63, dir = w >> 1, pidx = dir == 0 ? j + 1 : LC - j; const int gi = (l * 2 + dir) * 32 + g;
#pragma unroll
            for (int t = 0; t < 8; ++t) { const int n = n0 + t; const f32x2 cc = Cc[(dir * 2 + pl) * 64 + n]; const float cr = cc.x, ci = cc.y; const f32x2 a = pw[(dir * 33 + pidx) * 64 + n];
                v[t] = (w & 1) ? -(cr * a.y + ci * a.x) : (cr * a.x - ci * a.y); } }
        u32x4 o; o.x = pk2(v[0], v[1]); o.y = pk2(v[2], v[3]); o.z = pk2(v[4], v[5]); o.w = pk2(v[6], v[7]);
        *(u32x4*)(T + (size_t)(j * 16 + p) * AS5_PITCH + k0) = o; }
    bf16_t* W1 = (bf16_t*)(A->ws + WS_W1) + (size_t)g * 256 * 512;
    for (int e = tid; e < 32 * 64; e += 512) { const int n2 = ps * 32 + (e >> 6), kv = e & 63, k0 = kv * 8, i = k0 >> 4, q0 = k0 & 15; const int dir = n2 >> 7, isim = (n2 >> 6) & 1, n = n2 & 63;
        const int pidx = dir == 0 ? (LC - 1 - i) : i; const f32x2 a = pw[(dir * 33 + pidx) * 64 + n]; float v[8];
#pragma unroll
        for (int t = 0; t < 8; ++t) { const f32x2 bb = Bb[(dir * 64 + n) * 16 + q0 + t]; v[t] = isim ? (a.x * bb.y + a.y * bb.x) : (a.x * bb.x - a.y * bb.y); }
        u32x4 o; o.x = pk2(v[0], v[1]); o.y = pk2(v[2], v[3]); o.z = pk2(v[4], v[5]); o.w = pk2(v[6], v[7]);
        *(u32x4*)(W1 + (size_t)n2 * 512 + k0) = o; }
    __syncthreads();
}

__device__ __forceinline__ void s5_scan(KArgP A, int l, int wid  , int lane) {
    const int g = wid >> 4, b = (wid >> 1) & 7, dir = wid & 1, n = lane; const int gi = (l * 2 + dir) * 32 + g;
    float ar, ai; a_pow(A->in[3][gi * 64 + n], A->in[4][gi * 64 + n], expf(A->in[5][gi]), LC, ar, ai);
    const float* S = (const float*)(A->ws + WS_SST) + ((size_t)g * 1024 + b * 128) * 256 + dir * 128 + n;
    bf16_t* X = (bf16_t*)(A->ws + WS_AS5) + ((size_t)g * 1024 + b * 128) * AS5_PITCH + 512 + dir * 128 + n;
    float xr = 0.f, xi = 0.f;
    for (int c0 = 0; c0 < 128; c0 += 8) {
        float sr[8], si[8];
#pragma unroll
        for (int u = 0; u < 8; ++u) { const int c = dir == 0 ? (c0 + u) : (127 - c0 - u); sr[u] = S[(size_t)c * 256]; si[u] = S[(size_t)c * 256 + 64]; }
#pragma unroll
        for (int u = 0; u < 8; ++u) { const int c = dir == 0 ? (c0 + u) : (127 - c0 - u);
            X[(size_t)c * AS5_PITCH] = (bf16_t)f2bf(xr); X[(size_t)c * AS5_PITCH + 64] = (bf16_t)f2bf(xi);
            const float nr = ar * xr - ai * xi + sr[u], ni = ar * xi + ai * xr + si[u]; xr = nr; xi = ni; }
    }
}

__device__ __forceinline__ void phase_pool(const bf16_t* up, bf16_t* pooled, int gw, int NGW, int lane) {
    for (int it = gw; it < NB * 256; it += NGW) {
        const int b = it >> 8, tc = it & 255, t0 = tc * 16, grp = lane >> 4, win = 2 << grp, left = win >> 1, right = win - 1 - left;
        const bf16_t* base = up + (size_t)b * SEQ * 512 + lane * 8; bf16_t* ob = pooled + (size_t)b * SEQ * 512 + lane * 8;
        int lo = t0 - left < 0 ? 0 : t0 - left, hi = t0 + right + 1 > SEQ ? SEQ : t0 + right + 1;
        f32x4 s0 = {0.f, 0.f, 0.f, 0.f}, s1 = {0.f, 0.f, 0.f, 0.f};
        for (int s = lo; s < hi; ++s) { f32x4 a, c; unpack8(*(const u32x4*)(base + (size_t)s * 512), a, c); s0 += a; s1 += c; }
        for (int t = t0; t < t0 + 16; ++t) {
            f32x4 a, c; unpack8(*(const u32x4*)(base + (size_t)t * 512), a, c); const float inv = 1.0f / (float)(hi - lo);
            *(u32x4*)(ob + (size_t)t * 512) = pack8(s0 * inv - a, s1 * inv - c);
            if (t + right + 1 < SEQ) { f32x4 x, y; unpack8(*(const u32x4*)(base + (size_t)(t + right + 1) * 512), x, y); s0 += x; s1 += y; ++hi; }
            if (t - left >= 0) { f32x4 x, y; unpack8(*(const u32x4*)(base + (size_t)(t - left) * 512), x, y); s0 -= x; s1 -= y; ++lo; }
        }
    }
}

struct KVFrag { bf16x8 ka0, ka1, kb0, kb1; u32x2 va[4], vb[4]; };
__device__ __forceinline__ void tile_base(int tid, int r, int i0, int& rho, int& ib) {
    if (tid < 10) { const int jt = tid < 2 ? tid + 4 : (tid < 6 ? tid - 2 : tid); rho = r; ib = i0 - 64 + 16 * jt; }
    else if (tid < 22) { const int u = tid - 10, c = u / 3, uu = u - 3 * c; rho = (r + 4 * c) & 15; ib = i0 - 16 + 16 * uu; }
    else { const int v = tid - 22, rs = v / 6, w = v - 6 * rs; rho = 4 * rs; ib = i0 - 4 + 4 * w; }
}
__device__ __forceinline__ int clampi(int x, int lo, int hi) { return x < lo ? lo : (x > hi ? hi : x); }
__device__ __forceinline__ void attn_load(KVFrag& f, int pp, const bf16_t* Kb, const bf16_t* Vb, int r, int i0, int ql, int quad) {
    const int kq = ql >> 2, ks = ql & 3; const bool strided = pp < 11;
    int rho, ib;
    tile_base(2 * pp, r, i0, rho, ib);
    { const int kr = strided ? rho : rho + kq, ki = clampi(strided ? ib + ql : ib + ks, 0, 255); const bf16_t* p = Kb + (kr * 256 + ki) * 64; f.ka0 = *(const bf16x8*)p; f.ka1 = *(const bf16x8*)(p + 32);
      const int vr = strided ? rho : rho + quad, vi = clampi(strided ? ib + 4 * quad : ib, 0, 252) >> 2; const bf16_t* q = Vb + (vr * 64 + vi) * 256;
#pragma unroll
      for (int dt = 0; dt < 4; ++dt) f.va[dt] = *(const u32x2*)(q + dt * 64); }
    tile_base(2 * pp + 1, r, i0, rho, ib);
    { const int kr = strided ? rho : rho + kq, ki = clampi(strided ? ib + ql : ib + ks, 0, 255); const bf16_t* p = Kb + (kr * 256 + ki) * 64; f.kb0 = *(const bf16x8*)p; f.kb1 = *(const bf16x8*)(p + 32);
      const int vr = strided ? rho : rho + quad, vi = clampi(strided ? ib + 4 * quad : ib, 0, 252) >> 2; const bf16_t* q = Vb + (vr * 64 + vi) * 256;
#pragma unroll
      for (int dt = 0; dt < 4; ++dt) f.vb[dt] = *(const u32x2*)(q + dt * 64); }
}
struct AttnState { f32x4 o[4]; f32x4 ol; float m; };
__device__ __forceinline__ void attn_step(AttnState& st, const KVFrag& cur, int pp, bf16x8 qf0, bf16x8 qf1, int r, int i0, int tq, int quad, float nslope2, int lane) {
    const bool strided = pp < 11; const float Rf = pp < 5 ? 1024.f : (pp < 11 ? 256.f : 64.f);
    const float nm = -st.m;
    f32x4 sA = {nm, nm, nm, nm}, sB = {nm, nm, nm, nm};
    sA = __builtin_amdgcn_mfma_f32_16x16x32_bf16(cur.ka0, qf0, sA, 0, 0, 0); sA = __builtin_amdgcn_mfma_f32_16x16x32_bf16(cur.ka1, qf1, sA, 0, 0, 0);
    sB = __builtin_amdgcn_mfma_f32_16x16x32_bf16(cur.kb0, qf0, sB, 0, 0, 0); sB = __builtin_amdgcn_mfma_f32_16x16x32_bf16(cur.kb1, qf1, sB, 0, 0, 0);
    int rho, ib; float dA, dB;
    tile_base(2 * pp, r, i0, rho, ib); { const int rr = strided ? rho : rho + quad, ii = strided ? ib + 4 * quad : ib; dA = ((unsigned)ii < 256u) ? (float)(rr + 16 * ii - tq) : 1e9f; }
    tile_base(2 * pp + 1, r, i0, rho, ib); { const int rr = strided ? rho : rho + quad, ii = strided ? ib + 4 * quad : ib; dB = ((unsigned)ii < 256u) ? (float)(rr + 16 * ii - tq) : 1e9f; }
    float s[8]; float mx = -1e30f;
#pragma unroll
    for (int e = 0; e < 4; ++e) { const float xa = fabsf(dA + 16.f * e), xb = fabsf(dB + 16.f * e);
        s[e] = xa <= Rf ? fmaf(nslope2, xa, sA[e]) : -1e30f; s[4 + e] = xb <= Rf ? fmaf(nslope2, xb, sB[e]) : -1e30f; }
#pragma unroll
    for (int e = 0; e < 8; ++e) mx = fmaxf(mx, s[e]);
    if (pp == 0 || __builtin_amdgcn_ballot_w64(mx > 32.f) != 0ull) {
        mx = fmaxf(mx, shx(mx, 16, lane)); mx = fmaxf(mx, shx(mx, 32, lane));
        const float inc = pp == 0 ? mx : fmaxf(mx, 0.f), alpha = __builtin_amdgcn_exp2f(-inc); st.m += inc; st.ol = st.ol * alpha;
#pragma unroll
        for (int dt = 0; dt < 4; ++dt) st.o[dt] = st.o[dt] * alpha;
#pragma unroll
        for (int e = 0; e < 8; ++e) s[e] -= inc;
    }
    float p[8];
#pragma unroll
    for (int e = 0; e < 8; ++e) p[e] = __builtin_amdgcn_exp2f(s[e]);
    u32x4 pk; pk.x = cvt_pk_bf16(p[0], p[1]); pk.y = cvt_pk_bf16(p[2], p[3]); pk.z = cvt_pk_bf16(p[4], p[5]); pk.w = cvt_pk_bf16(p[6], p[7]);
    const bf16x8 pf = __builtin_bit_cast(bf16x8, pk);
    const u32x4 one4 = {0x3F803F80u, 0x3F803F80u, 0x3F803F80u, 0x3F803F80u};
    st.ol = __builtin_amdgcn_mfma_f32_16x16x32_bf16(__builtin_bit_cast(bf16x8, one4), pf, st.ol, 0, 0, 0);
#pragma unroll
    for (int dt = 0; dt < 4; ++dt) { u32x4 vv; vv.x = cur.va[dt].x; vv.y = cur.va[dt].y; vv.z = cur.vb[dt].x; vv.w = cur.vb[dt].y;
        st.o[dt] = __builtin_amdgcn_mfma_f32_16x16x32_bf16(__builtin_bit_cast(bf16x8, vv), pf, st.o[dt], 0, 0, 0); }
}
constexpr int ATT_KROW = 144;
constexpr int ATT_LDS_V = 16 * 24 * ATT_KROW;
__device__ __forceinline__ void attn_stage_window(LAS unsigned char* lds, const bf16_t* Kbh, const bf16_t* Vbh, int i0, int tid) {
    u32x4 kv[6], vv[6];
#pragma unroll
    for (int u = 0; u < 6; ++u) { const int t = tid + 512 * u, rho = t / 192, rem = t - rho * 192, irow = rem >> 3, c = rem & 7; const int i = clampi(i0 - 4 + irow, 0, 255);
        kv[u] = *(const u32x4*)(Kbh + (rho * 256 + i) * 64 + c * 8); }
#pragma unroll
    for (int u = 0; u < 6; ++u) { const int t = tid + 512 * u, rho = t / 192, rem = t - rho * 192, blk = rem >> 5, c = rem & 31; const int i4 = clampi((i0 >> 2) - 1 + blk, 0, 63);
        vv[u] = *(const u32x4*)(Vbh + (rho * 64 + i4) * 256 + c * 8); }
#pragma unroll
    for (int u = 0; u < 6; ++u) { const int t = tid + 512 * u, rho = t / 192, rem = t - rho * 192, irow = rem >> 3, c = rem & 7; *(LAS u32x4*)(lds + (rho * 24 + irow) * ATT_KROW + c * 16) = kv[u]; }
#pragma unroll
    for (int u = 0; u < 6; ++u) { const int t = tid + 512 * u, rho = t / 192, rem = t - rho * 192, blk = rem >> 5, c = rem & 31; *(LAS u32x4*)(lds + ATT_LDS_V + (rho * 6 + blk) * 512 + c * 16) = vv[u]; }
}
__device__ __forceinline__ void attn_load_lds(KVFrag& f, int pp, LAS unsigned char* lds, int ql, int quad) {
    const int kq = ql >> 2, ks = ql & 3;
#pragma unroll
    for (int half = 0; half < 2; ++half) { const int v = 2 * pp + half - 22, rs = v / 6, w = v - 6 * rs;
        const LAS unsigned char* kp = lds + ((4 * rs + kq) * 24 + 4 * w + ks) * ATT_KROW + quad * 16;
        const bf16x8 k0 = *(const LAS bf16x8*)kp, k1 = *(const LAS bf16x8*)(kp + 64);
        const LAS unsigned char* vp = lds + ATT_LDS_V + ((4 * rs + quad) * 6 + w) * 512 + ql * 8;
        u32x2 vv[4];
#pragma unroll
        for (int dt = 0; dt < 4; ++dt) vv[dt] = *(const LAS u32x2*)(vp + dt * 128);
        if (half == 0) { f.ka0 = k0; f.ka1 = k1; f.va[0] = vv[0]; f.va[1] = vv[1]; f.va[2] = vv[2]; f.va[3] = vv[3]; }
        else { f.kb0 = k0; f.kb1 = k1; f.vb[0] = vv[0]; f.vb[1] = vv[1]; f.vb[2] = vv[2]; f.vb[3] = vv[3]; } }
}
__device__ __forceinline__ void attn_group(const bf16_t* Q, const bf16_t* Kp, const bf16_t* Vt, bf16_t* O, int b, int h, int r, int i0, int lane, LAS unsigned char* lds) {
    const int ql = lane & 15, quad = lane >> 4;
    const int tq = r + 16 * (i0 + ql);
    const float nslope2 = -exp2f(-0.5f * (float)(h + 1)) * LOG2E;
    const size_t qrow = ((size_t)b * SEQ + tq) * 1024 + h * 64;
    const bf16x8 qf0 = *(const bf16x8*)(Q + qrow + quad * 8), qf1 = *(const bf16x8*)(Q + qrow + 32 + quad * 8);
    const bf16_t* Kb = Kp + (size_t)(b * 16 + h) * 262144 + quad * 8;
    const bf16_t* Vb = Vt + (size_t)(b * 16 + h) * 262144 + ql * 4;
    AttnState st;
#pragma unroll
    for (int dt = 0; dt < 4; ++dt) st.o[dt] = (f32x4){0.f, 0.f, 0.f, 0.f};
    st.m = 0.f; st.ol = (f32x4){0.f, 0.f, 0.f, 0.f};
    KVFrag fa, fb, fc;
    attn_load(fa, 0, Kb, Vb, r, i0, ql, quad); attn_load(fb, 1, Kb, Vb, r, i0, ql, quad);
    for (int pp = 0; pp < 9; pp += 3) {
        attn_load(fc, pp + 2, Kb, Vb, r, i0, ql, quad); attn_step(st, fa, pp, qf0, qf1, r, i0, tq, quad, nslope2, lane);
        attn_load(fa, pp + 3, Kb, Vb, r, i0, ql, quad); attn_step(st, fb, pp + 1, qf0, qf1, r, i0, tq, quad, nslope2, lane);
        if (pp + 4 < 11) attn_load(fb, pp + 4, Kb, Vb, r, i0, ql, quad);
        attn_step(st, fc, pp + 2, qf0, qf1, r, i0, tq, quad, nslope2, lane);
    }
    attn_step(st, fa, 9, qf0, qf1, r, i0, tq, quad, nslope2, lane); attn_step(st, fb, 10, qf0, qf1, r, i0, tq, quad, nslope2, lane);
#pragma unroll 1
    for (int pp = 11; pp < 23; ++pp) { attn_load_lds(fa, pp, lds, ql, quad); attn_step(st, fa, pp, qf0, qf1, r, i0, tq, quad, nslope2, lane); }
    const float inv = 1.0f / st.ol[0];
#pragma unroll
    for (int dt = 0; dt < 4; ++dt) { u32x2 w; w.x = cvt_pk_bf16(st.o[dt][0] * inv, st.o[dt][1] * inv); w.y = cvt_pk_bf16(st.o[dt][2] * inv, st.o[dt][3] * inv);
        *(u32x2*)(O + qrow + dt * 16 + 4 * quad) = w; }
}
__device__ __forceinline__ void phase_attn(const bf16_t* Q, const bf16_t* Kp, const bf16_t* Vt, bf16_t* O, int vcu, int G, int wave, int lane, LAS unsigned char* lds) {
    const int per_x = G >> 3, xcd = vcu / per_x, j = vcu - xcd * per_x;
    const int gpr = per_x * 16;
    for (int g0 = 0; g0 < 16 * 256; g0 += gpr) {
        const int gi0 = g0 + j * 16, bh = xcd * 16 + (gi0 >> 8), i0 = ((gi0 & 255) >> 4) * 16, b = bh >> 4, h = bh & 15;
        __syncthreads();
        { int t_ = wave * 64 + lane; asm volatile("" : "+v"(t_));
          attn_stage_window(lds, Kp + (size_t)bh * 262144, Vt + (size_t)bh * 262144, i0, t_); }
        __syncthreads();
#pragma unroll 1
        for (int k = 0; k < 2; ++k) { int l_ = lane; asm volatile("" : "+v"(l_)); attn_group(Q, Kp, Vt, O, b, h, k * 8 + wave, i0, l_, lds); }
    }
}

#define XB_TMO      128
#define XB_XCNT(j)  (256  + 64 * (j))
#define XB_XSUB(j)  (1280 + 64 * (j))
#define XB_XGEN(j)  (2304 + 64 * (j))
#define XB_TOP      3328
#define XB_TOPGEN   3392
#define XCD_BAR_WORDS 3456
#define XB_SPIN_CAP (1u << 18)

__device__ __forceinline__ unsigned xb_ld(unsigned* p)              { return __hip_atomic_load(p, __ATOMIC_RELAXED, __HIP_MEMORY_SCOPE_AGENT); }
__device__ __forceinline__ unsigned xb_add(unsigned* p, unsigned v) { return __hip_atomic_fetch_add(p, v, __ATOMIC_RELAXED, __HIP_MEMORY_SCOPE_AGENT); }
__device__ __forceinline__ unsigned xb_xcc_id() { return (unsigned)__builtin_amdgcn_s_getreg((3 << 11) | 20) & 0xFu; }
#define XB_SPIN(cond, bar) do { unsigned _sp = 0; while (cond) { __builtin_amdgcn_s_sleep(1); \
    if ((++_sp & 255u) == 0u) { if (xb_ld(&(bar)[XB_TMO])) break; if (_sp > XB_SPIN_CAP) { atomicAdd(&(bar)[XB_TMO], 1u); break; } } } } while (0)

struct XcdBarrier {
    unsigned* bar; unsigned x;
    volatile LAS unsigned* st;
};

__device__ __forceinline__ XcdBarrier xcd_barrier_post(unsigned* bar, volatile LAS unsigned* st) {
    XcdBarrier b; b.bar = bar; b.x = xb_xcc_id(); b.st = st;
    if (threadIdx.x == 0) (void)xb_add(&bar[XB_XCNT(b.x)], 1u);
    return b;
}
__device__ __forceinline__ void xcd_barrier_complete(unsigned* bar, unsigned x, unsigned& nloc, unsigned& nx) {
    const unsigned G = gridDim.x * gridDim.y * gridDim.z;
    unsigned sum, cnt, mine, sp = 0u;
    for (;;) {
        sum = 0u; cnt = 0u; mine = 0u;
#pragma unroll
        for (unsigned j = 0; j < 16; ++j) { const unsigned c = xb_ld(&bar[XB_XCNT(j)]); sum += c; cnt += (c > 0u) ? 1u : 0u; mine = (j == x) ? c : mine; }
        if (sum == G) break;
        __builtin_amdgcn_s_sleep(1);
        if ((++sp & 255u) == 0u) { if (xb_ld(&bar[XB_TMO])) break; if (sp > XB_SPIN_CAP) { atomicAdd(&bar[XB_TMO], 1u); break; } }
    }
    nloc = mine > 0u ? mine : 1u; nx = cnt > 0u ? cnt : 1u;
}

__device__ __forceinline__ void xcd_barrier(const XcdBarrier& b) {
    asm volatile("s_waitcnt vmcnt(0)" ::: "memory");
    __syncthreads();
    if (threadIdx.x == 0) {
        unsigned* bar = b.bar;
        __builtin_amdgcn_s_waitcnt(0);
        unsigned nloc = b.st[0], nx = b.st[1];
        if (nloc == 0u) { xcd_barrier_complete(bar, b.x, nloc, nx); b.st[0] = nloc; b.st[1] = nx; }
        const unsigned old = xb_add(&bar[XB_XSUB(b.x)], 1u);
        const unsigned gen = old / nloc;
        if (old + 1u == (gen + 1u) * nloc) {
            __builtin_amdgcn_fence(__ATOMIC_RELEASE, "agent");
            asm volatile("s_waitcnt vmcnt(0)" ::: "memory");
            const unsigned og = xb_add(&bar[XB_TOP], 1u);
            const unsigned tg = og / nx;
            if (og + 1u == (tg + 1u) * nx) xb_add(&bar[XB_TOPGEN], 1u);
            else XB_SPIN(xb_ld(&bar[XB_TOPGEN]) == tg, bar);
            __builtin_amdgcn_fence(__ATOMIC_ACQUIRE, "agent");
            xb_add(&bar[XB_XGEN(b.x)], 1u);
            asm volatile("s_waitcnt vmcnt(0)" ::: "memory");
        } else {
            XB_SPIN(xb_ld(&bar[XB_XGEN(b.x)]) == gen, bar);
            __builtin_amdgcn_fence(__ATOMIC_ACQUIRE, "agent");
            asm volatile("s_waitcnt vmcnt(0)" ::: "memory");
        }
    }
    __syncthreads();
}


#define XN ((bf16_t*)(ws + WS_XN))
#define UPOOL ((bf16_t*)(ws + WS_UPOOL))
#define AS5 ((bf16_t*)(ws + WS_AS5))
#define Qb ((bf16_t*)(ws + WS_Q))
#define Kb ((bf16_t*)(ws + WS_K))
#define VT ((bf16_t*)(ws + WS_VT))
#define SST ((float*)(ws + WS_SST))
#define POOLED ((bf16_t*)(ws + WS_POOLED))
#define YS5 ((bf16_t*)(ws + WS_YS5))
#define GT ((bf16_t*)(ws + WS_GT))
#define MERGED ((bf16_t*)(ws + WS_MERGED))
#define Yb ((bf16_t*)(ws + WS_Y))
#define HID ((bf16_t*)(ws + WS_HID))
#define Tt ((bf16_t*)(ws + WS_T))
#define W1t ((bf16_t*)(ws + WS_W1))
#define run_gemm(lds, S, K, lda, ldb, ...) run_gemm_(lds, S, K, lda, ldb, __VA_ARGS__, tid)
#ifndef BR_N
#define BR_N 2
#endif
#ifndef PHMASK
#define PHMASK 0xFFFF
#endif
constexpr int NSUB = 11;
constexpr int NPH = 1 + NSUB * NLAYER + 1;
constexpr int NOB = 1 << 30;
constexpr unsigned T1K = 256u * 1024 * 2, T512 = 256u * 512 * 2, TAS5 = 256u * AS5_PITCH * 2, T4K = 256u * 4096 * 2;
typedef pg8::SchedT<MTOK / 256, 12, MTOK / 256, NOB, 0u, T1K, 0u, T1K, 0u> SchedIn;
typedef pg8::SchedT<4, MTOK / 256, 4, 16, 0u, T1K, 0u, 1024u * 2, (unsigned)SEQ * 1024 * 2> SchedVt;
typedef pg8::SchedT<128, 1, 4, NOB, 1024u * AS5_PITCH * 2, TAS5, 256u * 512 * 2, 0u, 0u> SchedS1;
typedef pg8::SchedT<128, 2, 4, NOB, 1024u * AS5_PITCH * 2, TAS5, 512u * AS5_PITCH * 2, TAS5, 0u> SchedS3;
typedef pg8::SchedT<MTOK / 256, 2, MTOK / 256, NOB, 0u, T512, 0u, T512, 0u> SchedGlu;
typedef pg8::SchedT<MTOK / 256, 4, MTOK / 256, NOB, 0u, T1K, 0u, T1K, 0u> Sched1k;
typedef pg8::SchedT<MTOK / 256, 4, MTOK / 256, NOB, 0u, T512, 0u, T512, 0u> Sched512;
typedef pg8::SchedT<MTOK / 256, 16, MTOK / 256, NOB, 0u, T1K, 0u, T1K, 0u> SchedUp;
typedef pg8::SchedT<MTOK / 256, 4, MTOK / 256, NOB, 0u, T4K, 0u, T4K, 0u> SchedDn;
#define CP(x) ((const char*)(x))
__global__ void __launch_bounds__(512, 2) fwd_kernel(Args Araw) {
    extern __shared__ __attribute__((aligned(16))) unsigned char lds_raw[];
    LAS unsigned char* lds = (LAS unsigned char*)lds_raw;
    const int ph_hi = Araw.ph_hi; const int wave0 = __builtin_amdgcn_readfirstlane(threadIdx.x >> 6);
    volatile LAS unsigned* bst = (volatile LAS unsigned*)(lds + 131072 + 64);
    if (threadIdx.x < 2) bst[threadIdx.x] = 0u;
    __syncthreads();
    XcdBarrier xbar; xbar.bar = (unsigned*)Araw.ws; xbar.x = 0; xbar.st = bst;
    if (ph_hi - Araw.ph_lo > 1) xbar = xcd_barrier_post((unsigned*)Araw.ws, bst);
    for (int ph = Araw.ph_lo; ph < ph_hi; ++ph) {
        KArgP A = (KArgP)__builtin_amdgcn_kernarg_segment_ptr(); asm volatile("" : "+s"(A));
        unsigned char* ws = A->ws; float* hres = A->out;
        int lane, wave = wave0, bx = blockIdx.x;
        asm volatile("v_mbcnt_lo_u32_b32 %0, -1, 0\n\tv_mbcnt_hi_u32_b32 %0, -1, %0" : "=v"(lane)); asm volatile("" : "+s"(wave)); asm volatile("" : "+s"(bx));
        const int tid = wave * 64 + lane;
        const int G = gridDim.x, vcu = (G % 8 == 0) ? (bx % 8) * (G / 8) + bx / 8 : bx;
        const int gw = vcu * 8 + wave, NGW = G * 8, gtid = bx * 512 + tid, NT = G * 512;
        if (ph == 0) { if constexpr ((PHMASK >> 11) & 1) phase_convert(A, lds, gw, NGW, wave, lane, gtid, NT); }
        else if (ph == NPH - 1) { phase_norm<2>(hres, A->in[21], nullptr, hres, gw, NGW, lane); }
        else {
            const int l = (ph - 1) / NSUB, sub = (ph - 1) % NSUB;
            const bf16_t* WL = (const bf16_t*)(ws + WS_W + (size_t)l * W_LAYER_STRIDE);
            switch (sub) {
            case 0: if constexpr ((PHMASK >> 0) & 1) {
                for (int it = bx; it < 256; it += G) s5_tables(A, l, it >> 3, it & 7, lds, tid);
                if (l == 0) phase_norm<1>(A->in[0], A->in[1], XN, hres, gw, NGW, lane); else phase_norm<0>(hres, A->in[1] + (size_t)l * DM, XN, nullptr, gw, NGW, lane);
            } break;
            case 1: if constexpr ((PHMASK >> 1) & 1) {
                { SchedIn S{G, bx, CP(XN), CP(WL + W_IN)}; run_gemm(lds, S, 1024, 1024, 1024, FG1{AS5, UPOOL, Qb, Kb}); }
                { SchedVt S{G, bx, CP(WL + W_IN + (size_t)3072 * 1024), CP(XN)}; run_gemm(lds, S, 1024, 1024, 16 * 1024, FVt{VT}); }
            } break;
            case 2: if constexpr ((PHMASK >> 2) & 1) {
                { SchedS1 S{G, bx, CP(AS5), CP(W1t)}; run_gemm(lds, S, 512, AS5_PITCH, 512, FS1{SST}); }
                phase_attn(Qb, Kb, VT, Qb, vcu, G, wave, lane, lds);
            } break;
            case 3: if constexpr ((PHMASK >> 3) & 1) {
                if (wave < 2) { for (int w = bx * 2 + wave; w < 512; w += G * 2) s5_scan(A, l, w, lane); }
                phase_pool(UPOOL, POOLED, gw, NGW, lane);
            } break;
            case 4: if constexpr ((PHMASK >> 4) & 1) {
                SchedS3 S{G, bx, CP(AS5), CP(Tt)}; run_gemm(lds, S, AS5_PITCH, AS5_PITCH, AS5_PITCH, FS3{Yb});
            } break;
            case 5: if constexpr ((PHMASK >> 5) & 1) {
                SchedGlu S{G, bx, CP(Yb), CP(WL + W_GLU)}; run_gemm(lds, S, 512, 512, 512, FGlu{Yb, YS5});
            } break;
            case 6: {
                { Sched1k S{G, bx, CP(XN), CP(WL + W_IN + (size_t)4096 * 1024)}; run_gemm(lds, S, 1024, 1024, 1024, FGate{GT}); }
                { Sched512 S{G, bx, CP(YS5), CP(WL + W_BS)}; run_gemm(lds, S, 512, 512, 512, FBranch<0>{GT, MERGED}); }
                { Sched1k S{G, bx, CP(XN), CP(WL + W_IN + (size_t)5120 * 1024)}; run_gemm(lds, S, 1024, 1024, 1024, FGate{GT}); }
                { Sched512 S{G, bx, CP(POOLED), CP(WL + W_BP)}; run_gemm(lds, S, 512, 512, 512, FBranch<1>{GT, MERGED}); }
                { Sched1k S{G, bx, CP(XN), CP(WL + W_IN + (size_t)6144 * 1024)}; run_gemm(lds, S, 1024, 1024, 1024, FGate{GT}); }
                { Sched1k S{G, bx, CP(Qb), CP(WL + W_BA)}; run_gemm(lds, S, 1024, 1024, 1024, FBranch<2>{GT, MERGED}); }
            } break;
            case 7: { Sched1k S{G, bx, CP(MERGED), CP(WL + W_OUT)}; run_gemm(lds, S, 1024, 1024, 1024, FResid{hres}); } break;
            case 8: { phase_norm<0>(hres, A->in[18] + (size_t)l * DM, XN, nullptr, gw, NGW, lane); } break;
            case 9: { SchedUp S{G, bx, CP(XN), CP(WL + W_UP)}; run_gemm(lds, S, 1024, 1024, 1024, FUp{HID}); } break;
            case 10: { SchedDn S{G, bx, CP(HID), CP(WL + W_DN)}; run_gemm(lds, S, 4096, 4096, 4096, FResid{hres}); } break;
            }
        }
        if (ph + 1 < ph_hi && ph != 0) {
            if (ph_hi < 0) { __threadfence(); cg::this_grid().sync(); }
            { XcdBarrier xb; xb.bar = (unsigned*)A->ws; xb.x = xb_xcc_id(); xb.st = bst; xcd_barrier(xb); }
        }
    }
}

#ifndef LAST_PH
#define LAST_PH (NPH - 1)
#endif
#ifdef DUMP_OFF
__global__ void dump_kernel(const unsigned short* src, float* dst, size_t n) { for (size_t i = (size_t)blockIdx.x * blockDim.x + threadIdx.x; i < n; i += (size_t)gridDim.x * blockDim.x) dst[i] = __uint_as_float((unsigned)src[i] << 16); }
#endif
extern "C" void kernel_launch(void* const* d_in, const int* in_sizes, int n_in, void* d_out, int out_size, void* d_ws, size_t ws_size, hipStream_t stream) {
    static int grid = 0;
    if (grid == 0) {
        if (n_in != 22 || out_size != MTOK * DM || ws_size < WS_END) { fprintf(stderr, "kernel_launch: unexpected shapes (n_in %d, out %d, ws %zu < %zu)\n", n_in, out_size, ws_size, (size_t)WS_END); grid = -1; return; }
        int dev = 0, cus = 0, per_cu = 0;
        hipGetDevice(&dev); hipDeviceGetAttribute(&cus, hipDeviceAttributeMultiprocessorCount, dev);
        if (hipFuncSetAttribute((const void*)fwd_kernel, hipFuncAttributeMaxDynamicSharedMemorySize, LDS_BYTES) != hipSuccess) { fprintf(stderr, "kernel_launch: hipFuncSetAttribute failed\n"); grid = -1; return; }
        hipOccupancyMaxActiveBlocksPerMultiprocessor(&per_cu, (const void*)fwd_kernel, 512, LDS_BYTES);
        (void)hipGetLastError();
        if (per_cu < 1) fprintf(stderr, "kernel_launch: occupancy query says %d blocks per CU\n", per_cu);
        grid = cus;
        if (grid != 256) fprintf(stderr, "kernel_launch: %d CUs (tuned for 256)\n", grid);
        while ((NB * 16 * 256) % grid != 0 || grid % 8 != 0) --grid;
    }
    if (grid < 0) return;
    (void)hipMemsetAsync(d_ws, 0, 65536, stream);
    Args a{};
    for (int i = 0; i < 22; ++i) a.in[i] = (const float*)d_in[i];
    a.out = (float*)d_out; a.ws = (unsigned char*)d_ws;
#if ONE_LAUNCH
    a.ph_lo = 0; a.ph_hi = NPH;
    void* args[] = {&a};
    hipError_t e = hipLaunchCooperativeKernel((const void*)fwd_kernel, dim3(grid), dim3(512), args, LDS_BYTES, stream);
    if (e != hipSuccess) fprintf(stderr, "cooperative launch failed: %s (grid %d)\n", hipGetErrorString(e), grid);
#else
    for (int ph = 0; ph <= LAST_PH; ++ph) { a.ph_lo = ph; a.ph_hi = ph + 1; hipLaunchKernelGGL(fwd_kernel, dim3(grid), dim3(512), LDS_BYTES, stream, a); }
#ifdef DUMP_OFF
    hipLaunchKernelGGL(dump_kernel, dim3(2048), dim3(256), 0, stream, (const unsigned short*)((const char*)d_ws + (size_t)(DUMP_OFF)), (float*)d_out, (size_t)MTOK * DM);
#endif
#endif
}
```

```cpp
#include <hip/hip_runtime.h>
#include <hip/hip_cooperative_groups.h>
#include <cstdio>
#include <cstdint>
namespace cg = cooperative_groups;

#ifndef ONE_LAUNCH
#define ONE_LAUNCH 1
#endif

#define LAS __attribute__((address_space(3)))
#define PG8_LAS __attribute__((address_space(3)))
typedef unsigned short bf16_t;
typedef short bf16x8 __attribute__((ext_vector_type(8)));
typedef float f32x4 __attribute__((ext_vector_type(4)));
typedef float f32x2 __attribute__((ext_vector_type(2)));
typedef unsigned u32x4 __attribute__((ext_vector_type(4)));
typedef unsigned u32x2 __attribute__((ext_vector_type(2)));

constexpr int NB = 8, SEQ = 4096, DM = 1024, MTOK = NB * SEQ, DFF = 4096, NLAYER = 2;
constexpr float NORM_EPS = 1e-6f;
constexpr float LOG2E = 1.4426950408889634f;
constexpr float QSCALE = 0.125f * LOG2E;
constexpr int LC = 32;
constexpr int AS5_PITCH = 768;

constexpr size_t MiB = (size_t)1 << 20;
constexpr size_t WS_W = 1 * MiB, W_LAYER_STRIDE = 37 * MiB;
constexpr size_t W_IN = 0, W_GLU = 7340032, W_BS = 7602176, W_BP = 8126464, W_BA = 8650752, W_OUT = 9699328, W_UP = 10747904, W_DN = 14942208;
constexpr size_t WS_T = 75 * MiB, WS_W1 = 99 * MiB, WS_XN = 107 * MiB, WS_UPOOL = 171 * MiB, WS_AS5 = 203 * MiB, WS_Q = 251 * MiB, WS_K = 315 * MiB, WS_VT = 379 * MiB,
                 WS_SST = 443 * MiB, WS_END = 475 * MiB;
constexpr size_t WS_POOLED = WS_K, WS_YS5 = WS_K  , WS_GT = WS_VT, WS_MERGED = WS_UPOOL, WS_Y = WS_SST, WS_HID = WS_UPOOL;
constexpr int LDS_BYTES = 135168;

struct Args { const float* in[22]; float* out; unsigned char* ws; int ph_lo, ph_hi; };
typedef const __attribute__((address_space(4))) Args* KArgP;

typedef __bf16 bf16x2_t __attribute__((ext_vector_type(2)));
__device__ __forceinline__ unsigned cvt_pk_bf16(float lo, float hi) { const f32x2 v = {lo, hi}; const bf16x2_t b = __builtin_convertvector(v, bf16x2_t); return __builtin_bit_cast(unsigned, b); }
__device__ __forceinline__ u32x4 pack8(f32x4 a, f32x4 b) { u32x4 w; w.x = cvt_pk_bf16(a[0], a[1]); w.y = cvt_pk_bf16(a[2], a[3]); w.z = cvt_pk_bf16(b[0], b[1]); w.w = cvt_pk_bf16(b[2], b[3]); return w; }
__device__ __forceinline__ float bf_lo(unsigned w) { return __uint_as_float(w << 16); }
__device__ __forceinline__ float bf_hi(unsigned w) { return __uint_as_float(w & 0xffff0000u); }
__device__ __forceinline__ void unpack8(u32x4 w, f32x4& a, f32x4& b) { a = (f32x4){bf_lo(w.x), bf_hi(w.x), bf_lo(w.y), bf_hi(w.y)}; b = (f32x4){bf_lo(w.z), bf_hi(w.z), bf_lo(w.w), bf_hi(w.w)}; }
__device__ __forceinline__ float fast_sigmoid(float x) { return __builtin_amdgcn_rcpf(1.0f + __builtin_amdgcn_exp2f(-LOG2E * x)); }
__device__ __forceinline__ f32x4 sig4(f32x4 v) { return (f32x4){fast_sigmoid(v[0]), fast_sigmoid(v[1]), fast_sigmoid(v[2]), fast_sigmoid(v[3])}; }
__device__ __forceinline__ float gelu_tanh(float y) { const float u = 0.7978845608028654f * (y + 0.044715f * y * y * y); return y * fast_sigmoid(2.0f * u); }
__device__ __forceinline__ f32x4 gelu4(f32x4 v) { return (f32x4){gelu_tanh(v[0]), gelu_tanh(v[1]), gelu_tanh(v[2]), gelu_tanh(v[3])}; }
__device__ __forceinline__ float shx(float v, int o, int lane) { return __int_as_float(__builtin_amdgcn_ds_bpermute((lane ^ o) << 2, __float_as_int(v))); }
__device__ __forceinline__ float wave_sum(float v, int lane) {
#pragma unroll
    for (int o = 1; o < 64; o <<= 1) v += shx(v, o, lane);
    return v;
}

namespace pg8 {
constexpr int BM = 256, BK = 64, HALF = 128, HTB = HALF * BK * 2, STAGE_BYTES = 8 * HTB, NXCD = 8, WGM = 8;
__host__ __device__ __forceinline__ int lds_byte(int r, int c) { const int st = (r >> 4) * 2 + (c >> 5), rr = r & 15, cc = c & 31, ob = rr * 64 + cc * 2; return st * 1024 + (ob ^ (((ob >> 9) & 1) << 5)); }
__host__ __device__ __forceinline__ void stage_rc(int b, int& R, int& C) { const int st = b / 1024, sb = b % 1024, swz = sb ^ (((sb >> 9) & 1) << 5); R = (st >> 1) * 16 + swz / 64; C = (st & 1) * 32 + (swz % 64) / 2; }
__host__ __device__ __forceinline__ int perm32(int rho) { const int n = rho >> 4, i = rho & 15; return 8 * (i >> 2) + 4 * n + (i & 3); }

struct Unit { int pm, pn; const char* a; const char* b; int nt, kind; };
struct Gemm { int K, lda, ldb; };

template <int NM, int NN, int NMZ, int BDIV, unsigned AZ, unsigned AT, unsigned BZ, unsigned BLO, unsigned BHI>
struct SchedT {
    int G, c; const char* A; const char* B;
    __device__ __forceinline__ bool next(int i, Unit& u) const {
        constexpr int nwg = NM * NN;
        const int L = i * G + c; if (L >= nwg) return false;
        int wgid = L; { constexpr int q = nwg / NXCD, r = nwg % NXCD; const int xcd = wgid % NXCD, off = wgid / NXCD; wgid = (xcd < r ? xcd * (q + 1) : r * (q + 1) + (xcd - r) * q) + off; }
        constexpr int nig = WGM * NN; const int gid = wgid / nig, fm = gid * WGM, gsz = (NM - fm) < WGM ? (NM - fm) : WGM;
        u.pm = fm + ((wgid % nig) % gsz); u.pn = (wgid % nig) / gsz;
        const int z = u.pm / NMZ, pmz = u.pm - z * NMZ;
        u.a = A + (size_t)z * AZ + (size_t)pmz * AT;
        u.b = B + (size_t)z * BZ + (size_t)(u.pn / BDIV) * BHI + (size_t)(u.pn % BDIV) * BLO; u.nt = 0; u.kind = 0;
        return true;
    }
    __device__ __forceinline__ void a_ready(const Unit&) const {}
    __device__ __forceinline__ void done(const Unit&) const {}
};

struct EpiBuf { u32x4 a, b; };
template <class F> struct EpiT {
    static constexpr bool PERM = true, AFTER_DRAIN = false; F f;
    __device__ __forceinline__ void operator()(const f32x4 (&acc)[2][2][4][2], const Unit& u, int wr, int wc, int fr, int fq) const {
#pragma unroll
        for (int ai = 0; ai < 2; ++ai) {
            EpiBuf buf[4][2];
            if constexpr (F::NLOAD > 0) {
#pragma unroll
                for (int m = 0; m < 4; ++m)
#pragma unroll
                    for (int bj = 0; bj < 2; ++bj) f.load(u.pm * BM + ai * HALF + wr * 64 + m * 16 + fr, u.pn * BM + bj * HALF + wc * 32 + 8 * fq, buf[m][bj]);
            }
#pragma unroll
            for (int m = 0; m < 4; ++m)
#pragma unroll
                for (int bj = 0; bj < 2; ++bj) f.apply(u.pm * BM + ai * HALF + wr * 64 + m * 16 + fr, u.pn * BM + bj * HALF + wc * 32 + 8 * fq, acc[ai][bj][m][0], acc[ai][bj][m][1], buf[m][bj]);
            asm volatile("" ::: "memory");
        }
    }
    __device__ __forceinline__ void fused(f32x4 (&)[2][2][4][2], const Unit&, int, int, int, int, PG8_LAS unsigned char*, int, int) const {}
};

struct SchedBr {
    int G, c; const char* xn; const char* sp; const char* ya; const char* wgate; const char* wsp; const char* wba;
    __device__ __forceinline__ bool next(int i, Unit& u) const {
        constexpr int NM = 128, NN = 4, nwg = NM * NN; const int tile = i / 6, kind = i - 6 * tile;
        const int L = tile * G + c; if (L >= nwg) return false;
        int wgid = L; { constexpr int q = nwg / NXCD; const int xcd = wgid % NXCD, off = wgid / NXCD; wgid = xcd * q + off; }
        constexpr int nig = WGM * NN; const int gid = wgid / nig, fm = gid * WGM;
        u.pm = fm + ((wgid % nig) % WGM); u.pn = (wgid % nig) / WGM; u.kind = kind;
        const size_t ta = (size_t)u.pm * (256u * 1024 * 2), tb = (size_t)u.pn * (256u * 1024 * 2);
        if ((kind & 1) == 0) { u.a = xn + ta; u.b = wgate + (size_t)(kind >> 1) * (1024u * 1024 * 2) + tb; u.nt = 16; }
        else if (kind == 1) { u.a = sp + ta; u.b = wsp + tb; u.nt = 8; }
        else if (kind == 3) { u.a = sp + ta + 1024; u.b = wsp + tb + 1024; u.nt = 8; }
        else { u.a = ya + ta; u.b = wba + tb; u.nt = 16; }
        return true;
    }
    __device__ __forceinline__ void a_ready(const Unit&) const {}
    __device__ __forceinline__ void done(const Unit&) const {}
};
struct EpiBr {
    static constexpr bool PERM = true, AFTER_DRAIN = false; bf16_t* gt; bf16_t* mg;
    __device__ __forceinline__ void operator()(const f32x4 (&acc)[2][2][4][2], const Unit& u, int wr, int wc, int fr, int fq) const {
        const int kind = u.kind;
#pragma unroll
        for (int ai = 0; ai < 2; ++ai) {
            if (kind & 1) {
                EpiBuf buf[4][2];
#pragma unroll
                for (int m = 0; m < 4; ++m)
#pragma unroll
                    for (int bj = 0; bj < 2; ++bj) { const size_t o = (size_t)(u.pm * BM + ai * HALF + wr * 64 + m * 16 + fr) * 1024 + u.pn * BM + bj * HALF + wc * 32 + 8 * fq;
                        buf[m][bj].a = *(const u32x4*)(gt + o); if (kind > 1) buf[m][bj].b = *(const u32x4*)(mg + o); }
#pragma unroll
                for (int m = 0; m < 4; ++m)
#pragma unroll
                    for (int bj = 0; bj < 2; ++bj) { const size_t o = (size_t)(u.pm * BM + ai * HALF + wr * 64 + m * 16 + fr) * 1024 + u.pn * BM + bj * HALF + wc * 32 + 8 * fq;
                        f32x4 ga, gb; unpack8(buf[m][bj].a, ga, gb); f32x4 va = ga * acc[ai][bj][m][0], vb = gb * acc[ai][bj][m][1];
                        if (kind > 1) { f32x4 ma, mb; unpack8(buf[m][bj].b, ma, mb); va += ma; vb += mb; }
                        *(u32x4*)(mg + o) = pack8(va, vb); }
            } else {
#pragma unroll
                for (int m = 0; m < 4; ++m)
#pragma unroll
                    for (int bj = 0; bj < 2; ++bj) { const size_t o = (size_t)(u.pm * BM + ai * HALF + wr * 64 + m * 16 + fr) * 1024 + u.pn * BM + bj * HALF + wc * 32 + 8 * fq;
                        *(u32x4*)(gt + o) = pack8(sig4(acc[ai][bj][m][0]), sig4(acc[ai][bj][m][1])); }
            }
            asm volatile("" ::: "memory");
        }
    }
    __device__ __forceinline__ void fused(f32x4 (&)[2][2][4][2], const Unit&, int, int, int, int, PG8_LAS unsigned char*, int, int) const {}
};

template <class Epi, class Sched, bool ALIGN_EPI = false, bool SP2 = false>
__device__ __forceinline__ void gemm_phase(PG8_LAS unsigned char* lds, const Gemm g, const Sched& S, const Epi& E, const int tid) {
    const int  wid = __builtin_amdgcn_readfirstlane(tid >> 6), lane = tid & 63, wr = wid >> 2, wc = wid & 3, fr = lane & 15, fq = lane >> 4;
    const int K = g.K, nt = K / BK;
    unsigned voffA[2], voffB[2];
#pragma unroll
    for (int i = 0; i < 2; ++i) { int R, C; stage_rc(tid * 16 + i * 8192, R, C); const int Rb = Epi::PERM ? ((R & ~31) + perm32(R & 31)) : R;
        voffA[i] = (unsigned)(R * g.lda + C) * 2u; voffB[i] = (unsigned)(Rb * g.ldb + C) * 2u; }
    const size_t kstep = (size_t)(BK * 2);
    const size_t hstepA = (size_t)HALF * g.lda * 2, hstepB = (size_t)HALF * g.ldb * 2;
    const unsigned ldsw = (unsigned)wid * 1024u;
    const int aoff = lds_byte(wr * 64 + fr, fq * 8), boff = lds_byte(wc * 32 + fr, fq * 8);
#define PG8_SA(b, h) (((b) * 2 + (h)) * HTB)
#define PG8_SB(b, h) ((4 + (b) * 2 + (h)) * HTB)
#define PG8_STAGE(bufoff, gbase, voff) do { _Pragma("unroll") for (int _i = 0; _i < 2; ++_i) \
        __builtin_amdgcn_global_load_lds((const unsigned*)((const char*)(gbase) + (voff)[_i]), (PG8_LAS unsigned*)(lds + (bufoff) + ldsw + _i * 8192), 16, 0, 0); } while (0)
#define PG8_LDA(dst, b, h) do { _Pragma("unroll") for (int m = 0; m < 4; ++m) _Pragma("unroll") for (int k = 0; k < 2; ++k) dst[m][k] = *(const PG8_LAS bf16x8*)(lds + PG8_SA(b, h) + aoff + m * 2048 + k * 1024); } while (0)
#define PG8_LDB(dst, b, h) do { _Pragma("unroll") for (int n = 0; n < 2; ++n) _Pragma("unroll") for (int k = 0; k < 2; ++k) dst[n][k] = *(const PG8_LAS bf16x8*)(lds + PG8_SB(b, h) + boff + n * 2048 + k * 1024); } while (0)
#define PG8_MMA(ai, bj, At, Bt) do { __builtin_amdgcn_s_setprio(1); _Pragma("unroll") for (int m = 0; m < 4; ++m) _Pragma("unroll") for (int n = 0; n < 2; ++n) _Pragma("unroll") for (int k = 0; k < 2; ++k) \
        acc[ai][bj][m][n] = __builtin_amdgcn_mfma_f32_16x16x32_bf16(Bt[n][k], At[m][k], acc[ai][bj][m][n], 0, 0, 0); __builtin_amdgcn_s_setprio(0); } while (0)
#define PG8_WAIT_V(n) asm volatile("s_waitcnt vmcnt(" #n ")" ::: "memory")
#define PG8_WAIT_L(n) asm volatile("s_waitcnt lgkmcnt(" #n ")" ::: "memory")
#define PG8_BAR __builtin_amdgcn_s_barrier()
#define PG8_SCHED __builtin_amdgcn_sched_barrier(0)
    Unit cur, nxt; int ui = 0;
    if (!S.next(0, cur)) return;
    f32x4 acc[2][2][4][2];
#pragma unroll
    for (int a = 0; a < 2; ++a)
#pragma unroll
        for (int b = 0; b < 2; ++b)
#pragma unroll
            for (int m = 0; m < 4; ++m)
#pragma unroll
                for (int n = 0; n < 2; ++n) acc[a][b][m][n] = (f32x4){0.f, 0.f, 0.f, 0.f};
    bf16x8 At[4][2], B0[2][2], B1[2][2];
    const char* cA = cur.a; const char* cB = cur.b;
    S.a_ready(cur);
    if constexpr (SP2) {
        PG8_STAGE(PG8_SB(0, 0), cB, voffB); PG8_STAGE(PG8_SB(0, 1), cB + hstepB, voffB); PG8_STAGE(PG8_SA(0, 0), cA, voffA); PG8_STAGE(PG8_SA(0, 1), cA + hstepA, voffA);
        if (wr == 1) PG8_BAR;
        PG8_WAIT_V(2); PG8_BAR;
        PG8_STAGE(PG8_SB(1, 0), cB + kstep, voffB); PG8_STAGE(PG8_SA(1, 0), cA + kstep, voffA); PG8_STAGE(PG8_SB(1, 1), cB + hstepB + kstep, voffB);
        PG8_WAIT_V(6); PG8_BAR;
    } else {
        PG8_STAGE(PG8_SB(0, 0), cB, voffB); PG8_STAGE(PG8_SA(0, 0), cA, voffA); PG8_STAGE(PG8_SB(0, 1), cB + hstepB, voffB); PG8_STAGE(PG8_SA(0, 1), cA + hstepA, voffA);
        if (wr == 1) PG8_BAR;
        PG8_WAIT_V(4); PG8_BAR;
        PG8_STAGE(PG8_SB(1, 0), cB + kstep, voffB); PG8_STAGE(PG8_SA(1, 0), cA + kstep, voffA); PG8_STAGE(PG8_SB(1, 1), cB + hstepB + kstep, voffB);
        PG8_WAIT_V(6); PG8_BAR;
    }
    for (;;) {
        const bool has_next = S.next(ui + 1, nxt);
        const char* nA = has_next ? nxt.a : cA; const char* nB = has_next ? nxt.b : cB;
        const int nt_u = cur.nt > 0 ? cur.nt : nt;
        for (int t = 0; t < nt_u; t += 2) {
            const bool last = (t == nt_u - 2);
            const char* a1 = cA + (size_t)(t + 1) * kstep;
            const char* a2 = last ? nA : cA + (size_t)(t + 2) * kstep; const char* b2 = last ? nB : cB + (size_t)(t + 2) * kstep;
            const char* a3 = a2 + kstep; const char* b3 = b2 + kstep;
            if (last && has_next) S.a_ready(nxt);
            if constexpr (SP2) {
            PG8_LDB(B0, 0, 0); PG8_LDB(B1, 0, 1); PG8_SCHED; PG8_LDA(At, 0, 0); PG8_STAGE(PG8_SA(1, 1), a1 + hstepA, voffA);
            PG8_WAIT_V(8); PG8_WAIT_L(0); PG8_BAR; PG8_MMA(0, 0, At, B0); PG8_MMA(0, 1, At, B1); PG8_BAR; PG8_SCHED;
            PG8_LDA(At, 0, 1); PG8_STAGE(PG8_SB(0, 0), b2, voffB); PG8_STAGE(PG8_SB(0, 1), b2 + hstepB, voffB); PG8_STAGE(PG8_SA(0, 0), a2, voffA);
            PG8_WAIT_V(8); PG8_WAIT_L(0); PG8_BAR; PG8_MMA(1, 0, At, B0); PG8_MMA(1, 1, At, B1); PG8_BAR; PG8_SCHED;
            PG8_LDB(B0, 1, 0); PG8_LDB(B1, 1, 1); PG8_SCHED; PG8_LDA(At, 1, 0); PG8_STAGE(PG8_SA(0, 1), a2 + hstepA, voffA);
            PG8_WAIT_V(8); PG8_WAIT_L(0); PG8_BAR; PG8_MMA(0, 0, At, B0); PG8_MMA(0, 1, At, B1); PG8_BAR; PG8_SCHED;
            PG8_LDA(At, 1, 1); PG8_STAGE(PG8_SB(1, 0), b3, voffB); PG8_STAGE(PG8_SB(1, 1), b3 + hstepB, voffB); PG8_STAGE(PG8_SA(1, 0), a3, voffA);
            PG8_WAIT_V(8); PG8_WAIT_L(0); PG8_BAR; PG8_MMA(1, 0, At, B0); PG8_MMA(1, 1, At, B1); PG8_BAR; PG8_SCHED;
            } else {
            PG8_LDB(B0, 0, 0); PG8_SCHED; PG8_LDA(At, 0, 0); PG8_STAGE(PG8_SA(1, 1), a1 + hstepA, voffA);
            PG8_WAIT_L(8); PG8_BAR; PG8_WAIT_L(0); PG8_MMA(0, 0, At, B0); PG8_BAR; PG8_SCHED;
            PG8_LDB(B1, 0, 1); PG8_STAGE(PG8_SB(0, 0), b2, voffB);
            PG8_BAR; PG8_WAIT_L(0); PG8_MMA(0, 1, At, B1); PG8_BAR;
            PG8_LDA(At, 0, 1); PG8_STAGE(PG8_SA(0, 0), a2, voffA);
            PG8_BAR; PG8_WAIT_L(0); PG8_MMA(1, 0, At, B0); PG8_BAR; PG8_SCHED;
            PG8_STAGE(PG8_SB(0, 1), b2 + hstepB, voffB);
            PG8_WAIT_V(6); PG8_BAR; PG8_MMA(1, 1, At, B1); PG8_BAR;
            PG8_LDB(B0, 1, 0); PG8_SCHED; PG8_LDA(At, 1, 0); PG8_STAGE(PG8_SA(0, 1), a2 + hstepA, voffA);
            PG8_WAIT_L(8); PG8_BAR; PG8_WAIT_L(0); PG8_MMA(0, 0, At, B0); PG8_BAR; PG8_SCHED;
            PG8_LDB(B1, 1, 1); PG8_STAGE(PG8_SB(1, 0), b3, voffB);
            PG8_BAR; PG8_WAIT_L(0); PG8_MMA(0, 1, At, B1); PG8_BAR;
            PG8_LDA(At, 1, 1); PG8_STAGE(PG8_SA(1, 0), a3, voffA);
            PG8_BAR; PG8_WAIT_L(0); PG8_MMA(1, 0, At, B0); PG8_BAR; PG8_SCHED;
            PG8_STAGE(PG8_SB(1, 1), b3 + hstepB, voffB);
            PG8_WAIT_V(6); PG8_BAR; PG8_MMA(1, 1, At, B1); PG8_BAR;
            }
        }
        if constexpr (ALIGN_EPI) { if (wr == 0) PG8_BAR; }
        if constexpr (!Epi::AFTER_DRAIN) { E(acc, cur, wr, wc, fr, fq); S.done(cur); }
        if (!has_next) break;
#pragma unroll
        for (int a = 0; a < 2; ++a)
#pragma unroll
            for (int b = 0; b < 2; ++b)
#pragma unroll
                for (int m = 0; m < 4; ++m)
#pragma unroll
                    for (int n = 0; n < 2; ++n) acc[a][b][m][n] = (f32x4){0.f, 0.f, 0.f, 0.f};
        cur = nxt; cA = nA; cB = nB; ++ui;
        if constexpr (ALIGN_EPI) { if (wr == 1) PG8_BAR; }
    }
    PG8_WAIT_V(0);
    if constexpr (!ALIGN_EPI) { if (wr == 0) PG8_BAR; }
    PG8_BAR;
    if constexpr (Epi::AFTER_DRAIN) { E.fused(acc, cur, wr, wc, fr, fq, lds, wid, lane); S.done(cur); }
#undef PG8_SA
#undef PG8_SB
#undef PG8_STAGE
#undef PG8_LDA
#undef PG8_LDB
#undef PG8_MMA
#undef PG8_WAIT_V
#undef PG8_WAIT_L
#undef PG8_BAR
#undef PG8_SCHED
}
}

struct FG1 { static constexpr int NLOAD = 0;
    bf16_t *as5, *upool, *q, *k;
    __device__ __forceinline__ void apply(int row, int col, f32x4 a, f32x4 b, const pg8::EpiBuf& lb) const {
        if (col < 512) { const int g = col >> 4, q0 = col & 15, bb = row >> 12, t = row & 4095, c = t >> 5, i = t & 31;
            *(u32x4*)(as5 + ((size_t)(g * 1024 + bb * 128 + c) * AS5_PITCH + i * 16 + q0)) = pack8(a, b); }
        else if (col < 1024) *(u32x4*)(upool + (size_t)row * 512 + (col - 512)) = pack8(a, b);
        else if (col < 2048) *(u32x4*)(q + (size_t)row * 1024 + (col - 1024)) = pack8(a * QSCALE, b * QSCALE);
        else { const int hd = col - 2048, h = hd >> 6, d0 = hd & 63, bb = row >> 12, t = row & 4095;
            *(u32x4*)(k + ((size_t)(((bb * 16 + h) * 16 + (t & 15)) * 256 + (t >> 4)) * 64 + d0)) = pack8(a, b); }
    }
};
struct FPlain { static constexpr int NLOAD = 0; bf16_t* o; int ldc; __device__ __forceinline__ void apply(int row, int col, f32x4 a, f32x4 b, const pg8::EpiBuf& lb) const { *(u32x4*)(o + (size_t)row * ldc + col) = pack8(a, b); } };
struct FVt { static constexpr int NLOAD = 0;
    bf16_t* v;
    __device__ __forceinline__ void apply(int row, int col, f32x4 a, f32x4 b, const pg8::EpiBuf& lb) const {
        const int h = row >> 6, d = row & 63, bb = col >> 12, rho = (col >> 8) & 15, i = col & 255;
        bf16_t* p = v + ((size_t)((((bb * 16 + h) * 16 + rho) * 64 + (i >> 2)) * 64 + d)) * 4;
        u32x2 w0, w1; w0.x = cvt_pk_bf16(a[0], a[1]); w0.y = cvt_pk_bf16(a[2], a[3]); w1.x = cvt_pk_bf16(b[0], b[1]); w1.y = cvt_pk_bf16(b[2], b[3]);
        *(u32x2*)p = w0; *(u32x2*)(p + 256) = w1; }
};
struct FS1 { static constexpr int NLOAD = 0; float* s; __device__ __forceinline__ void apply(int row, int col, f32x4 a, f32x4 b, const pg8::EpiBuf& lb) const { f32x4* p = (f32x4*)(s + (size_t)row * 256 + col); p[0] = a; p[1] = b; } };
struct FS3 { static constexpr int NLOAD = 0;
    bf16_t* y;
    __device__ __forceinline__ void apply(int row, int col, f32x4 a, f32x4 b, const pg8::EpiBuf& lb) const {
        const int g = row >> 10, bc = row & 1023, bb = bc >> 7, c = bc & 127, j = col >> 4, p0 = col & 15;
        const size_t tok = (size_t)bb * 4096 + c * 32 + j;
        *(u32x4*)(y + tok * 512 + g * 16 + p0) = pack8(gelu4(a), gelu4(b)); }
};
struct FGlu { static constexpr int NLOAD = 1; const bf16_t* y; bf16_t* o;
    __device__ __forceinline__ void load(int row, int col, pg8::EpiBuf& lb) const { lb.a = *(const u32x4*)(y + (size_t)row * 512 + col); }
    __device__ __forceinline__ void apply(int row, int col, f32x4 a, f32x4 b, const pg8::EpiBuf& lb) const {
        f32x4 ya, yb; unpack8(lb.a, ya, yb);
        *(u32x4*)(o + (size_t)row * 1024 + col) = pack8(ya * sig4(a), yb * sig4(b)); }
};
struct FGate { static constexpr int NLOAD = 0; bf16_t* gt; __device__ __forceinline__ void apply(int row, int col, f32x4 a, f32x4 b, const pg8::EpiBuf& lb) const { *(u32x4*)(gt + (size_t)row * 1024 + col) = pack8(sig4(a), sig4(b)); } };
template <int MODE> struct FBranch { static constexpr int NLOAD = 2; const bf16_t* gt; bf16_t* mg;
    __device__ __forceinline__ void load(int row, int col, pg8::EpiBuf& lb) const { const size_t o = (size_t)row * 1024 + col; lb.a = *(const u32x4*)(gt + o); if (MODE) lb.b = *(const u32x4*)(mg + o); }
    __device__ __forceinline__ void apply(int row, int col, f32x4 a, f32x4 b, const pg8::EpiBuf& lb) const {
        const size_t o = (size_t)row * 1024 + col; f32x4 ga, gb; unpack8(lb.a, ga, gb);
        f32x4 va = ga * a, vb = gb * b;
        if (MODE) { f32x4 ma, mb; unpack8(lb.b, ma, mb); va += ma; vb += mb; }
        *(u32x4*)(mg + o) = pack8(va, vb); }
};
struct FResid { static constexpr int NLOAD = 2; float* h;
    __device__ __forceinline__ void load(int row, int col, pg8::EpiBuf& lb) const { const u32x4* p = (const u32x4*)(h + (size_t)row * 1024 + col); lb.a = p[0]; lb.b = p[1]; }
    __device__ __forceinline__ void apply(int row, int col, f32x4 a, f32x4 b, const pg8::EpiBuf& lb) const {
        f32x4* p = (f32x4*)(h + (size_t)row * 1024 + col); p[0] = __builtin_bit_cast(f32x4, lb.a) + a; p[1] = __builtin_bit_cast(f32x4, lb.b) + b; }
};
struct FUp { static constexpr int NLOAD = 0; bf16_t* hid;
    __device__ __forceinline__ void apply(int row, int col, f32x4 a, f32x4 b, const pg8::EpiBuf& lb) const {
        f32x4 ra, rb;
#pragma unroll
        for (int i = 0; i < 4; ++i) { const float x = fmaxf(a[i], 0.f), y = fmaxf(b[i], 0.f); ra[i] = x * x; rb[i] = y * y; }
        *(u32x4*)(hid + (size_t)row * 4096 + col) = pack8(ra, rb); }
};

template <class SC, class F> __device__ __forceinline__ void run_gemm_(LAS unsigned char* lds, const SC& S, int K, int lda, int ldb, const F& f, int tid) {
    __builtin_amdgcn_fence(__ATOMIC_ACQUIRE, "agent");
    asm volatile("" : "+v"(tid));
    pg8::Gemm g{K, lda, ldb}; pg8::EpiT<F> E{f};
    pg8::gemm_phase<pg8::EpiT<F>, SC, true, true>(lds, g, S, E, tid);
}

__device__ __forceinline__ unsigned f2bf(float f) { unsigned u = __builtin_bit_cast(unsigned, f); return (u + 0x7fffu + ((u >> 16) & 1u)) >> 16; }
__device__ __forceinline__ unsigned pk2(float lo, float hi) { return f2bf(lo) | (f2bf(hi) << 16); }
__device__ __forceinline__ void transpose_item(const float* W, int K, int N, bf16_t* WT, int pitch, LAS float* scr, int item, int lane) {
    const int nblk = N / 32, kb = item / nblk, nb = item % nblk, k0 = 64 * kb, n0 = 32 * nb;
    float wv[32];
#pragma unroll
    for (int i = 0; i < 32; ++i) wv[i] = W[(size_t)(k0 + 2 * i + (lane >> 5)) * N + n0 + (lane & 31)];
#pragma unroll
    for (int i = 0; i < 32; ++i) scr[(2 * i + (lane >> 5)) * 33 + (lane & 31)] = wv[i];
    asm volatile("s_waitcnt lgkmcnt(0)" ::: "memory");
    const int c = lane & 7;
#pragma unroll
    for (int j = 0; j < 4; ++j) { const int n = (lane >> 3) + 8 * j; const LAS float* s = scr + (8 * c) * 33 + n;
        u32x4 o; o.x = pk2(s[0 * 33], s[1 * 33]); o.y = pk2(s[2 * 33], s[3 * 33]); o.z = pk2(s[4 * 33], s[5 * 33]); o.w = pk2(s[6 * 33], s[7 * 33]);
        *(u32x4*)(WT + (size_t)(n0 + n) * pitch + k0 + 8 * c) = o; }
    asm volatile("s_waitcnt lgkmcnt(0)" ::: "memory");
}
__device__ __forceinline__ void phase_convert(KArgP A, LAS unsigned char* lds, int gw, int NGW, int wave, int lane, int gtid, int NT) {
    LAS float* scr = (LAS float*)(lds + wave * 16384);
    for (int l = 0; l < NLAYER; ++l) {
        bf16_t* WL = (bf16_t*)(A->ws + WS_W + (size_t)l * W_LAYER_STRIDE);
        const float* srcs[7] = {A->in[2] + (size_t)l * 1024 * 7168, A->in[11] + (size_t)l * 512 * 512, A->in[14] + (size_t)l * 512 * 1024, A->in[16] + (size_t)l * 1024 * 1024,
                                A->in[17] + (size_t)l * 1024 * 1024, A->in[19] + (size_t)l * 1024 * 4096, A->in[20] + (size_t)l * 4096 * 1024};
        const int Ks[7] = {1024, 512, 512, 1024, 1024, 1024, 4096}, Ns[7] = {7168, 512, 1024, 1024, 1024, 4096, 1024};
        const size_t offs[7] = {W_IN, W_GLU, W_BS, W_BA, W_OUT, W_UP, W_DN};
#pragma unroll
        for (int w = 0; w < 7; ++w) { const int items = (Ks[w] / 64) * (Ns[w] / 32);
            const int pitch = (w == 2) ? 1024 : Ks[w];
            for (int it = gw; it < items; it += NGW) transpose_item(srcs[w], Ks[w], Ns[w], WL + offs[w], pitch, scr, it, lane); }
        const float* pw = A->in[12] + (size_t)l * 4 * 128 * 128; const float* psc = A->in[13] + (size_t)l * 512; const float* wbp = A->in[15] + (size_t)l * 512 * 1024;
        bf16_t* WP = WL + W_BS + 512;
        for (int e = gtid; e < 1024 * 512; e += NT) { const int k = __builtin_amdgcn_readfirstlane(e >> 10), n = e & 1023, g = k >> 7;
            const float* pr = pw + (size_t)k * 128; const float* sc = psc + g * 128; const float* wb = wbp + (size_t)(g * 128) * 1024 + n; float acc = 0.f;
#pragma unroll 8
            for (int d = 0; d < 128; ++d) acc += (pr[d] * sc[d]) * wb[(size_t)d * 1024];
            WP[(size_t)n * 1024 + k] = (bf16_t)f2bf(acc); }
    }
}

template <int MODE  >
__device__ __forceinline__ void phase_norm(const float* src, const float* gain, bf16_t* xn, float* dst, int gw, int NGW, int lane) {
    f32x4 gv[4];
#pragma unroll
    for (int j = 0; j < 4; ++j) gv[j] = *((const f32x4*)gain + lane + 64 * j);
    for (int m = gw; m < MTOK; m += NGW) {
        const f32x4* xr = (const f32x4*)(src + (size_t)m * DM) + lane; f32x4 v[4]; float s = 0.f;
#pragma unroll
        for (int j = 0; j < 4; ++j) { v[j] = xr[64 * j]; s += (v[j].x * v[j].x + v[j].y * v[j].y) + (v[j].z * v[j].z + v[j].w * v[j].w); }
        const float r = 1.0f / sqrtf(wave_sum(s, lane) * (1.0f / DM) + NORM_EPS);
        if (MODE == 1) { f32x4* o = (f32x4*)(dst + (size_t)m * DM) + lane;
#pragma unroll
            for (int j = 0; j < 4; ++j) o[64 * j] = v[j]; }
        if (MODE == 2) { f32x4* o = (f32x4*)(dst + (size_t)m * DM) + lane;
#pragma unroll
            for (int j = 0; j < 4; ++j) o[64 * j] = v[j] * r * gv[j]; }
        else { u32x2* o = (u32x2*)(xn + (size_t)m * DM) + lane;
#pragma unroll
            for (int j = 0; j < 4; ++j) { const f32x4 y = v[j] * r * gv[j]; u32x2 w; w.x = cvt_pk_bf16(y.x, y.y); w.y = cvt_pk_bf16(y.z, y.w); o[64 * j] = w; } }
    }
}

__device__ __forceinline__ void sincos_d(double ang, double& s, double& c) {
    const double x = ang * 0.63661977236758134308; const double q = rint(x); const float y = (float)((x - q) * 1.57079632679489661923); const float y2 = y * y;
    const float sp = y * (1.0f + y2 * (-1.0f / 6 + y2 * (1.0f / 120 + y2 * (-1.0f / 5040 + y2 * (1.0f / 362880)))));
    const float cp = 1.0f + y2 * (-0.5f + y2 * (1.0f / 24 + y2 * (-1.0f / 720 + y2 * (1.0f / 40320 + y2 * (-1.0f / 3628800)))));
    const int qi = ((int)q) & 3;
    s = (double)((qi == 0) ? sp : (qi == 1) ? cp : (qi == 2) ? -sp : -cp);
    c = (double)((qi == 0) ? cp : (qi == 1) ? -sp : (qi == 2) ? -cp : sp);
}
__device__ __forceinline__ void a_pow(float lr, float li, float dt, int d, float& re, float& im) {
    const float mag = expf(lr * dt * (float)d); double s, c; sincos_d((double)li * (double)dt * (double)d, s, c); re = mag * (float)c; im = mag * (float)s;
}
__device__ __forceinline__ void s5_tables(KArgP A, int l, int g, int ps, LAS unsigned char* lds, int tid) {
    LAS f32x2* pw = (LAS f32x2*)lds;
    LAS f32x2* Bb = (LAS f32x2*)(lds + 33792);
    LAS float* Kt = (LAS float*)(lds + 50176);
    const float* lam_re = A->in[3]; const float* lam_im = A->in[4]; const float* log_dt = A->in[5];
    const float* b_re = A->in[6]; const float* b_im = A->in[7]; const float* c_re = A->in[8]; const float* c_im = A->in[9]; const float* dsk = A->in[10];
    for (int e = tid; e < 2 * 33 * 64; e += 512) { const int dir = e / (33 * 64), rem = e - dir * 33 * 64, d = rem >> 6, n = rem & 63; const int gi = (l * 2 + dir) * 32 + g;
        float re, im; a_pow(lam_re[gi * 64 + n], lam_im[gi * 64 + n], expf(log_dt[gi]), d, re, im); pw[e] = (f32x2){re, im}; }
    for (int e = tid; e < 2 * 64 * 16; e += 512) { const int dir = e >> 10, n = (e >> 4) & 63, q = e & 15; const int gi = (l * 2 + dir) * 32 + g;
        const float lr = lam_re[gi * 64 + n], li = lam_im[gi * 64 + n]; float ar, ai; a_pow(lr, li, expf(log_dt[gi]), 1, ar, ai);
        const double nr = (double)ar - 1.0, ni = (double)ai, den = (double)lr * lr + (double)li * li; const double cr = (nr * lr + ni * li) / den, ci = (ni * lr - nr * li) / den;
        const float br = b_re[((size_t)gi * 64 + n) * 16 + q], bi = b_im[((size_t)gi * 64 + n) * 16 + q];
        Bb[e] = (f32x2){(float)(cr * br - ci * bi), (float)(cr * bi + ci * br)}; }
    LAS f32x2* Cc = (LAS f32x2*)(lds + 58368);
    if (tid < 256) { const int dir = tid >> 7, pl = (tid >> 6) & 1, n = tid & 63; const size_t ci_ = ((size_t)((l * 2 + dir) * 32 + g) * 16 + ps * 2 + pl) * 64 + n; Cc[tid] = (f32x2){c_re[ci_], c_im[ci_]}; }
    __syncthreads();
    for (int e = tid; e < 2 * 32 * 2 * 16; e += 512) { const int dir = e >> 10, d = (e >> 5) & 31, pl = (e >> 4) & 1, q = e & 15; float acc = 0.f;
#pragma unroll 8
        for (int n = 0; n < 64; ++n) { const f32x2 w = pw[(dir * 33 + d) * 64 + n], bb = Bb[(dir * 64 + n) * 16 + q], cc = Cc[(dir * 2 + pl) * 64 + n];
            const float zr = w.x * bb.x - w.y * bb.y, zi = w.x * bb.y + w.y * bb.x; acc += cc.x * zr - cc.y * zi; }
        Kt[e] = acc; }
    __syncthreads();
    bf16_t* T = (bf16_t*)(A->ws + WS_T) + (size_t)g * 512 * AS5_PITCH;
    for (int e = tid; e < 64 * 96; e += 512) { const int rr = e / 96, kv = e - rr * 96, j = rr >> 1, pl = rr & 1, p = ps * 2 + pl, k0 = kv * 8; float v[8];
        if (k0 < 512) { const int i = k0 >> 4, q0 = k0 & 15;
#pragma unroll
            for (int t = 0; t < 8; ++t) { const int q = q0 + t; float x = 0.f;
                if (i <= j) x += Kt[((0 * 32 + (j - i)) * 2 + pl) * 16 + q];
                if (i >= j) x += Kt[((1 * 32 + (i - j)) * 2 + pl) * 16 + q];
                if (i == j && q == p) x += dsk[(size_t)l * 512 + g * 16 + p];
                v[t] = x; } }
        else { const int w = (k0 - 512) >> 6, n0 = (k0 - 512) & 63, dir = w >> 1, pidx = dir == 0 ? j + 1 : LC - j; const int gi = (l * 2 + dir) * 32 + g;
#pragma unroll
            for (int t = 0; t < 8; ++t) { const int n = n0 + t; const f32x2 cc = Cc[(dir * 2 + pl) * 64 + n]; const float cr = cc.x, ci = cc.y; const f32x2 a = pw[(dir * 33 + pidx) * 64 + n];
                v[t] = (w & 1) ? -(cr * a.y + ci * a.x) : (cr * a.x - ci * a.y); } }
        u32x4 o; o.x = pk2(v[0], v[1]); o.y = pk2(v[2], v[3]); o.z = pk2(v[4], v[5]); o.w = pk2(v[6], v[7]);
        *(u32x4*)(T + (size_t)(j * 16 + p) * AS5_PITCH + k0) = o; }
    bf16_t* W1 = (bf16_t*)(A->ws + WS_W1) + (size_t)g * 256 * 512;
    for (int e = tid; e < 32 * 64; e += 512) { const int n2 = ps * 32 + (e >> 6), kv = e & 63, k0 = kv * 8, i = k0 >> 4, q0 = k0 & 15; const int dir = n2 >> 7, isim = (n2 >> 6) & 1, n = n2 & 63;
        const int pidx = dir == 0 ? (LC - 1 - i) : i; const f32x2 a = pw[(dir * 33 + pidx) * 64 + n]; float v[8];
#pragma unroll
        for (int t = 0; t < 8; ++t) { const f32x2 bb = Bb[(dir * 64 + n) * 16 + q0 + t]; v[t] = isim ? (a.x * bb.y + a.y * bb.x) : (a.x * bb.x - a.y * bb.y); }
        u32x4 o; o.x = pk2(v[0], v[1]); o.y = pk2(v[2], v[3]); o.z = pk2(v[4], v[5]); o.w = pk2(v[6], v[7]);
        *(u32x4*)(W1 + (size_t)n2 * 512 + k0) = o; }
    __syncthreads();
}

__device__ __forceinline__ void s5_scan(KArgP A, int l, int wid  , int lane) {
    const int g = wid >> 4, b = (wid >> 1) & 7, dir = wid & 1, n = lane; const int gi = (l * 2 + dir) * 32 + g;
    float ar, ai; a_pow(A->in[3][gi * 64 + n], A->in[4][gi * 64 + n], expf(A->in[5][gi]), LC, ar, ai);
    const float* S = (const float*)(A->ws + WS_SST) + ((size_t)g * 1024 + b * 128) * 256 + dir * 128 + n;
    bf16_t* X = (bf16_t*)(A->ws + WS_AS5) + ((size_t)g * 1024 + b * 128) * AS5_PITCH + 512 + dir * 128 + n;
    float xr = 0.f, xi = 0.f;
    for (int c0 = 0; c0 < 128; c0 += 8) {
        float sr[8], si[8];
#pragma unroll
        for (int u = 0; u < 8; ++u) { const int c = dir == 0 ? (c0 + u) : (127 - c0 - u); sr[u] = S[(size_t)c * 256]; si[u] = S[(size_t)c * 256 + 64]; }
#pragma unroll
        for (int u = 0; u < 8; ++u) { const int c = dir == 0 ? (c0 + u) : (127 - c0 - u);
            X[(size_t)c * AS5_PITCH] = (bf16_t)f2bf(xr); X[(size_t)c * AS5_PITCH + 64] = (bf16_t)f2bf(xi);
            const float nr = ar * xr - ai * xi + sr[u], ni = ar * xi + ai * xr + si[u]; xr = nr; xi = ni; }
    }
}

__device__ __forceinline__ void phase_pool(const bf16_t* up, bf16_t* pooled, int gw, int NGW, int lane) {
    for (int it = gw; it < NB * 256; it += NGW) {
        const int b = it >> 8, tc = it & 255, t0 = tc * 16, grp = lane >> 4, win = 2 << grp, left = win >> 1, right = win - 1 - left;
        const bf16_t* base = up + (size_t)b * SEQ * 512 + lane * 8; bf16_t* ob = pooled + (size_t)b * SEQ * 1024 + 512 + lane * 8;
        int lo = t0 - left < 0 ? 0 : t0 - left, hi = t0 + right + 1 > SEQ ? SEQ : t0 + right + 1;
        f32x4 s0 = {0.f, 0.f, 0.f, 0.f}, s1 = {0.f, 0.f, 0.f, 0.f};
        for (int s = lo; s < hi; ++s) { f32x4 a, c; unpack8(*(const u32x4*)(base + (size_t)s * 512), a, c); s0 += a; s1 += c; }
        for (int t = t0; t < t0 + 16; ++t) {
            f32x4 a, c; unpack8(*(const u32x4*)(base + (size_t)t * 512), a, c); const float inv = 1.0f / (float)(hi - lo);
            *(u32x4*)(ob + (size_t)t * 1024) = pack8(s0 * inv - a, s1 * inv - c);
            if (t + right + 1 < SEQ) { f32x4 x, y; unpack8(*(const u32x4*)(base + (size_t)(t + right + 1) * 512), x, y); s0 += x; s1 += y; ++hi; }
            if (t - left >= 0) { f32x4 x, y; unpack8(*(const u32x4*)(base + (size_t)(t - left) * 512), x, y); s0 -= x; s1 -= y; ++lo; }
        }
    }
}

struct KVFrag { bf16x8 ka0, ka1, kb0, kb1; u32x2 va[4], vb[4]; };
__device__ __forceinline__ void tile_base(int tid, int r, int i0, int& rho, int& ib) {
    if (tid < 10) { const int jt = tid < 2 ? tid + 4 : (tid < 6 ? tid - 2 : tid); rho = r; ib = i0 - 64 + 16 * jt; }
    else if (tid < 22) { const int u = tid - 10, c = u / 3, uu = u - 3 * c; rho = (r + 4 * c) & 15; ib = i0 - 16 + 16 * uu; }
    else { const int v = tid - 22, rs = v / 6, w = v - 6 * rs; rho = 4 * rs; ib = i0 - 4 + 4 * w; }
}
__device__ __forceinline__ int clampi(int x, int lo, int hi) { return x < lo ? lo : (x > hi ? hi : x); }
__device__ __forceinline__ void attn_load(KVFrag& f, int pp, const bf16_t* Kb, const bf16_t* Vb, int r, int i0, int ql, int quad) {
    const int kq = ql >> 2, ks = ql & 3; const bool strided = pp < 11;
    int rho, ib;
    tile_base(2 * pp, r, i0, rho, ib);
    { const int kr = strided ? rho : rho + kq, ki = clampi(strided ? ib + ql : ib + ks, 0, 255); const bf16_t* p = Kb + (kr * 256 + ki) * 64; f.ka0 = *(const bf16x8*)p; f.ka1 = *(const bf16x8*)(p + 32);
      const int vr = strided ? rho : rho + quad, vi = clampi(strided ? ib + 4 * quad : ib, 0, 252) >> 2; const bf16_t* q = Vb + (vr * 64 + vi) * 256;
#pragma unroll
      for (int dt = 0; dt < 4; ++dt) f.va[dt] = *(const u32x2*)(q + dt * 64); }
    tile_base(2 * pp + 1, r, i0, rho, ib);
    { const int kr = strided ? rho : rho + kq, ki = clampi(strided ? ib + ql : ib + ks, 0, 255); const bf16_t* p = Kb + (kr * 256 + ki) * 64; f.kb0 = *(const bf16x8*)p; f.kb1 = *(const bf16x8*)(p + 32);
      const int vr = strided ? rho : rho + quad, vi = clampi(strided ? ib + 4 * quad : ib, 0, 252) >> 2; const bf16_t* q = Vb + (vr * 64 + vi) * 256;
#pragma unroll
      for (int dt = 0; dt < 4; ++dt) f.vb[dt] = *(const u32x2*)(q + dt * 64); }
}
struct AttnState { f32x4 o[4]; f32x4 ol; float m; };
__device__ __forceinline__ void attn_step(AttnState& st, const KVFrag& cur, int pp, bf16x8 qf0, bf16x8 qf1, int r, int i0, int tq, int quad, float nslope2, int lane) {
    const bool strided = pp < 11; const float Rf = pp < 5 ? 1024.f : (pp < 11 ? 256.f : 64.f);
    const float nm = -st.m;
    f32x4 sA = {nm, nm, nm, nm}, sB = {nm, nm, nm, nm};
    sA = __builtin_amdgcn_mfma_f32_16x16x32_bf16(cur.ka0, qf0, sA, 0, 0, 0); sA = __builtin_amdgcn_mfma_f32_16x16x32_bf16(cur.ka1, qf1, sA, 0, 0, 0);
    sB = __builtin_amdgcn_mfma_f32_16x16x32_bf16(cur.kb0, qf0, sB, 0, 0, 0); sB = __builtin_amdgcn_mfma_f32_16x16x32_bf16(cur.kb1, qf1, sB, 0, 0, 0);
    int rho, ib; float dA, dB;
    tile_base(2 * pp, r, i0, rho, ib); { const int rr = strided ? rho : rho + quad, ii = strided ? ib + 4 * quad : ib; dA = ((unsigned)ii < 256u) ? (float)(rr + 16 * ii - tq) : 1e9f; }
    tile_base(2 * pp + 1, r, i0, rho, ib); { const int rr = strided ? rho : rho + quad, ii = strided ? ib + 4 * quad : ib; dB = ((unsigned)ii < 256u) ? (float)(rr + 16 * ii - tq) : 1e9f; }
    float s[8]; float mx = -1e30f;
#pragma unroll
    for (int e = 0; e < 4; ++e) { const float xa = fabsf(dA + 16.f * e), xb = fabsf(dB + 16.f * e);
        s[e] = xa <= Rf ? fmaf(nslope2, xa, sA[e]) : -1e30f; s[4 + e] = xb <= Rf ? fmaf(nslope2, xb, sB[e]) : -1e30f; }
#pragma unroll
    for (int e = 0; e < 8; ++e) mx = fmaxf(mx, s[e]);
    if (pp == 0 || __builtin_amdgcn_ballot_w64(mx > 32.f) != 0ull) {
        mx = fmaxf(mx, shx(mx, 16, lane)); mx = fmaxf(mx, shx(mx, 32, lane));
        const float inc = pp == 0 ? mx : fmaxf(mx, 0.f), alpha = __builtin_amdgcn_exp2f(-inc); st.m += inc; st.ol = st.ol * alpha;
#pragma unroll
        for (int dt = 0; dt < 4; ++dt) st.o[dt] = st.o[dt] * alpha;
#pragma unroll
        for (int e = 0; e < 8; ++e) s[e] -= inc;
    }
    float p[8];
#pragma unroll
    for (int e = 0; e < 8; ++e) p[e] = __builtin_amdgcn_exp2f(s[e]);
    u32x4 pk; pk.x = cvt_pk_bf16(p[0], p[1]); pk.y = cvt_pk_bf16(p[2], p[3]); pk.z = cvt_pk_bf16(p[4], p[5]); pk.w = cvt_pk_bf16(p[6], p[7]);
    const bf16x8 pf = __builtin_bit_cast(bf16x8, pk);
    const u32x4 one4 = {0x3F803F80u, 0x3F803F80u, 0x3F803F80u, 0x3F803F80u};
    st.ol = __builtin_amdgcn_mfma_f32_16x16x32_bf16(__builtin_bit_cast(bf16x8, one4), pf, st.ol, 0, 0, 0);
#pragma unroll
    for (int dt = 0; dt < 4; ++dt) { u32x4 vv; vv.x = cur.va[dt].x; vv.y = cur.va[dt].y; vv.z = cur.vb[dt].x; vv.w = cur.vb[dt].y;
        st.o[dt] = __builtin_amdgcn_mfma_f32_16x16x32_bf16(__builtin_bit_cast(bf16x8, vv), pf, st.o[dt], 0, 0, 0); }
}
constexpr int ATT_KROW = 144;
constexpr int ATT_LDS_V = 16 * 24 * ATT_KROW;
__device__ __forceinline__ void attn_stage_window(LAS unsigned char* lds, const bf16_t* Kbh, const bf16_t* Vbh, int i0, int tid) {
    u32x4 kv[6], vv[6];
#pragma unroll
    for (int u = 0; u < 6; ++u) { const int t = tid + 512 * u, rho = t / 192, rem = t - rho * 192, irow = rem >> 3, c = rem & 7; const int i = clampi(i0 - 4 + irow, 0, 255);
        kv[u] = *(const u32x4*)(Kbh + (rho * 256 + i) * 64 + c * 8); }
#pragma unroll
    for (int u = 0; u < 6; ++u) { const int t = tid + 512 * u, rho = t / 192, rem = t - rho * 192, blk = rem >> 5, c = rem & 31; const int i4 = clampi((i0 >> 2) - 1 + blk, 0, 63);
        vv[u] = *(const u32x4*)(Vbh + (rho * 64 + i4) * 256 + c * 8); }
#pragma unroll
    for (int u = 0; u < 6; ++u) { const int t = tid + 512 * u, rho = t / 192, rem = t - rho * 192, irow = rem >> 3, c = rem & 7; *(LAS u32x4*)(lds + (rho * 24 + irow) * ATT_KROW + c * 16) = kv[u]; }
#pragma unroll
    for (int u = 0; u < 6; ++u) { const int t = tid + 512 * u, rho = t / 192, rem = t - rho * 192, blk = rem >> 5, c = rem & 31; *(LAS u32x4*)(lds + ATT_LDS_V + (rho * 6 + blk) * 512 + c * 16) = vv[u]; }
}
__device__ __forceinline__ void attn_load_lds(KVFrag& f, int pp, LAS unsigned char* lds, int ql, int quad) {
    const int kq = ql >> 2, ks = ql & 3;
#pragma unroll
    for (int half = 0; half < 2; ++half) { const int v = 2 * pp + half - 22, rs = v / 6, w = v - 6 * rs;
        const LAS unsigned char* kp = lds + ((4 * rs + kq) * 24 + 4 * w + ks) * ATT_KROW + quad * 16;
        const bf16x8 k0 = *(const LAS bf16x8*)kp, k1 = *(const LAS bf16x8*)(kp + 64);
        const LAS unsigned char* vp = lds + ATT_LDS_V + ((4 * rs + quad) * 6 + w) * 512 + ql * 8;
        u32x2 vv[4];
#pragma unroll
        for (int dt = 0; dt < 4; ++dt) vv[dt] = *(const LAS u32x2*)(vp + dt * 128);
        if (half == 0) { f.ka0 = k0; f.ka1 = k1; f.va[0] = vv[0]; f.va[1] = vv[1]; f.va[2] = vv[2]; f.va[3] = vv[3]; }
        else { f.kb0 = k0; f.kb1 = k1; f.vb[0] = vv[0]; f.vb[1] = vv[1]; f.vb[2] = vv[2]; f.vb[3] = vv[3]; } }
}
__device__ __forceinline__ void attn_group(const bf16_t* Q, const bf16_t* Kp, const bf16_t* Vt, bf16_t* O, int b, int h, int r, int i0, int lane, LAS unsigned char* lds) {
    const int ql = lane & 15, quad = lane >> 4;
    const int tq = r + 16 * (i0 + ql);
    const float nslope2 = -exp2f(-0.5f * (float)(h + 1)) * LOG2E;
    const size_t qrow = ((size_t)b * SEQ + tq) * 1024 + h * 64;
    const bf16x8 qf0 = *(const bf16x8*)(Q + qrow + quad * 8), qf1 = *(const bf16x8*)(Q + qrow + 32 + quad * 8);
    const bf16_t* Kb = Kp + (size_t)(b * 16 + h) * 262144 + quad * 8;
    const bf16_t* Vb = Vt + (size_t)(b * 16 + h) * 262144 + ql * 4;
    AttnState st;
#pragma unroll
    for (int dt = 0; dt < 4; ++dt) st.o[dt] = (f32x4){0.f, 0.f, 0.f, 0.f};
    st.m = 0.f; st.ol = (f32x4){0.f, 0.f, 0.f, 0.f};
    KVFrag fa, fb, fc;
    attn_load(fa, 0, Kb, Vb, r, i0, ql, quad); attn_load(fb, 1, Kb, Vb, r, i0, ql, quad);
    for (int pp = 0; pp < 9; pp += 3) {
        attn_load(fc, pp + 2, Kb, Vb, r, i0, ql, quad); attn_step(st, fa, pp, qf0, qf1, r, i0, tq, quad, nslope2, lane);
        attn_load(fa, pp + 3, Kb, Vb, r, i0, ql, quad); attn_step(st, fb, pp + 1, qf0, qf1, r, i0, tq, quad, nslope2, lane);
        if (pp + 4 < 11) attn_load(fb, pp + 4, Kb, Vb, r, i0, ql, quad);
        attn_step(st, fc, pp + 2, qf0, qf1, r, i0, tq, quad, nslope2, lane);
    }
    attn_step(st, fa, 9, qf0, qf1, r, i0, tq, quad, nslope2, lane); attn_step(st, fb, 10, qf0, qf1, r, i0, tq, quad, nslope2, lane);
#pragma unroll 1
    for (int pp = 11; pp < 23; ++pp) { attn_load_lds(fa, pp, lds, ql, quad); attn_step(st, fa, pp, qf0, qf1, r, i0, tq, quad, nslope2, lane); }
    const float inv = 1.0f / st.ol[0];
#pragma unroll
    for (int dt = 0; dt < 4; ++dt) { u32x2 w; w.x = cvt_pk_bf16(st.o[dt][0] * inv, st.o[dt][1] * inv); w.y = cvt_pk_bf16(st.o[dt][2] * inv, st.o[dt][3] * inv);
        *(u32x2*)(O + qrow + dt * 16 + 4 * quad) = w; }
}
__device__ __forceinline__ void phase_attn(const bf16_t* Q, const bf16_t* Kp, const bf16_t* Vt, bf16_t* O, int vcu, int G, int wave, int lane, LAS unsigned char* lds) {
    const int per_x = G >> 3, xcd = vcu / per_x, j = vcu - xcd * per_x;
    const int gpr = per_x * 16;
    for (int g0 = 0; g0 < 16 * 256; g0 += gpr) {
        const int gi0 = g0 + j * 16, bh = xcd * 16 + (gi0 >> 8), i0 = ((gi0 & 255) >> 4) * 16, b = bh >> 4, h = bh & 15;
        __syncthreads();
        { int t_ = wave * 64 + lane; asm volatile("" : "+v"(t_));
          attn_stage_window(lds, Kp + (size_t)bh * 262144, Vt + (size_t)bh * 262144, i0, t_); }
        __syncthreads();
#pragma unroll 1
        for (int k = 0; k < 2; ++k) { int l_ = lane; asm volatile("" : "+v"(l_)); attn_group(Q, Kp, Vt, O, b, h, k * 8 + wave, i0, l_, lds); }
    }
}

#define XB_TMO      128
#define XB_XCNT(j)  (256  + 64 * (j))
#define XB_XSUB(j)  (1280 + 64 * (j))
#define XB_XGEN(j)  (2304 + 64 * (j))
#define XB_TOP      3328
#define XB_TOPGEN   3392
#define XCD_BAR_WORDS 3456
#define XB_SPIN_CAP (1u << 18)

__device__ __forceinline__ unsigned xb_ld(unsigned* p)              { return __hip_atomic_load(p, __ATOMIC_RELAXED, __HIP_MEMORY_SCOPE_AGENT); }
__device__ __forceinline__ unsigned xb_add(unsigned* p, unsigned v) { return __hip_atomic_fetch_add(p, v, __ATOMIC_RELAXED, __HIP_MEMORY_SCOPE_AGENT); }
__device__ __forceinline__ unsigned xb_xcc_id() { return (unsigned)__builtin_amdgcn_s_getreg((3 << 11) | 20) & 0xFu; }
#define XB_SPIN(cond, bar) do { unsigned _sp = 0; while (cond) { __builtin_amdgcn_s_sleep(1); \
    if ((++_sp & 255u) == 0u) { if (xb_ld(&(bar)[XB_TMO])) break; if (_sp > XB_SPIN_CAP) { atomicAdd(&(bar)[XB_TMO], 1u); break; } } } } while (0)

struct XcdBarrier {
    unsigned* bar; unsigned x;
    volatile LAS unsigned* st;
};

__device__ __forceinline__ XcdBarrier xcd_barrier_post(unsigned* bar, volatile LAS unsigned* st) {
    XcdBarrier b; b.bar = bar; b.x = xb_xcc_id(); b.st = st;
    if (threadIdx.x == 0) (void)xb_add(&bar[XB_XCNT(b.x)], 1u);
    return b;
}
__device__ __forceinline__ void xcd_barrier_complete(unsigned* bar, unsigned x, unsigned& nloc, unsigned& nx) {
    const unsigned G = gridDim.x * gridDim.y * gridDim.z;
    unsigned sum, cnt, mine, sp = 0u;
    for (;;) {
        sum = 0u; cnt = 0u; mine = 0u;
#pragma unroll
        for (unsigned j = 0; j < 16; ++j) { const unsigned c = xb_ld(&bar[XB_XCNT(j)]); sum += c; cnt += (c > 0u) ? 1u : 0u; mine = (j == x) ? c : mine; }
        if (sum == G) break;
        __builtin_amdgcn_s_sleep(1);
        if ((++sp & 255u) == 0u) { if (xb_ld(&bar[XB_TMO])) break; if (sp > XB_SPIN_CAP) { atomicAdd(&bar[XB_TMO], 1u); break; } }
    }
    nloc = mine > 0u ? mine : 1u; nx = cnt > 0u ? cnt : 1u;
}

__device__ __forceinline__ void xcd_barrier(const XcdBarrier& b) {
    asm volatile("s_waitcnt vmcnt(0)" ::: "memory");
    __syncthreads();
    if (threadIdx.x == 0) {
        unsigned* bar = b.bar;
        __builtin_amdgcn_s_waitcnt(0);
        unsigned nloc = b.st[0], nx = b.st[1];
        if (nloc == 0u) { xcd_barrier_complete(bar, b.x, nloc, nx); b.st[0] = nloc; b.st[1] = nx; }
        const unsigned old = xb_add(&bar[XB_XSUB(b.x)], 1u);
        const unsigned gen = old / nloc;
        if (old + 1u == (gen + 1u) * nloc) {
            __builtin_amdgcn_fence(__ATOMIC_RELEASE, "agent");
            asm volatile("s_waitcnt vmcnt(0)" ::: "memory");
            const unsigned og = xb_add(&bar[XB_TOP], 1u);
            const unsigned tg = og / nx;
            if (og + 1u == (tg + 1u) * nx) xb_add(&bar[XB_TOPGEN], 1u);
            else XB_SPIN(xb_ld(&bar[XB_TOPGEN]) == tg, bar);
            __builtin_amdgcn_fence(__ATOMIC_ACQUIRE, "agent");
            xb_add(&bar[XB_XGEN(b.x)], 1u);
            asm volatile("s_waitcnt vmcnt(0)" ::: "memory");
        } else {
            XB_SPIN(xb_ld(&bar[XB_XGEN(b.x)]) == gen, bar);
            __builtin_amdgcn_fence(__ATOMIC_ACQUIRE, "agent");
            asm volatile("s_waitcnt vmcnt(0)" ::: "memory");
        }
    }
    __syncthreads();
}


#define XN ((bf16_t*)(ws + WS_XN))
#define UPOOL ((bf16_t*)(ws + WS_UPOOL))
#define AS5 ((bf16_t*)(ws + WS_AS5))
#define Qb ((bf16_t*)(ws + WS_Q))
#define Kb ((bf16_t*)(ws + WS_K))
#define VT ((bf16_t*)(ws + WS_VT))
#define SST ((float*)(ws + WS_SST))
#define POOLED ((bf16_t*)(ws + WS_POOLED))
#define YS5 ((bf16_t*)(ws + WS_YS5))
#define GT ((bf16_t*)(ws + WS_GT))
#define MERGED ((bf16_t*)(ws + WS_MERGED))
#define Yb ((bf16_t*)(ws + WS_Y))
#define HID ((bf16_t*)(ws + WS_HID))
#define Tt ((bf16_t*)(ws + WS_T))
#define W1t ((bf16_t*)(ws + WS_W1))
#define run_gemm(lds, S, K, lda, ldb, ...) run_gemm_(lds, S, K, lda, ldb, __VA_ARGS__, tid)
#ifndef BR_N
#define BR_N 2
#endif
#ifndef PHMASK
#define PHMASK 0xFFFF
#endif
constexpr int NSUB = 11;
constexpr int NPH = 1 + NSUB * NLAYER + 1;
constexpr int NOB = 1 << 30;
constexpr unsigned T1K = 256u * 1024 * 2, T512 = 256u * 512 * 2, TAS5 = 256u * AS5_PITCH * 2, T4K = 256u * 4096 * 2;
typedef pg8::SchedT<MTOK / 256, 12, MTOK / 256, NOB, 0u, T1K, 0u, T1K, 0u> SchedIn;
typedef pg8::SchedT<4, MTOK / 256, 4, 16, 0u, T1K, 0u, 1024u * 2, (unsigned)SEQ * 1024 * 2> SchedVt;
typedef pg8::SchedT<128, 1, 4, NOB, 1024u * AS5_PITCH * 2, TAS5, 256u * 512 * 2, 0u, 0u> SchedS1;
typedef pg8::SchedT<128, 2, 4, NOB, 1024u * AS5_PITCH * 2, TAS5, 512u * AS5_PITCH * 2, TAS5, 0u> SchedS3;
typedef pg8::SchedT<MTOK / 256, 2, MTOK / 256, NOB, 0u, T512, 0u, T512, 0u> SchedGlu;
typedef pg8::SchedT<MTOK / 256, 4, MTOK / 256, NOB, 0u, T1K, 0u, T1K, 0u> Sched1k;
typedef pg8::SchedT<MTOK / 256, 4, MTOK / 256, NOB, 0u, T512, 0u, T512, 0u> Sched512;
typedef pg8::SchedT<MTOK / 256, 16, MTOK / 256, NOB, 0u, T1K, 0u, T1K, 0u> SchedUp;
typedef pg8::SchedT<MTOK / 256, 4, MTOK / 256, NOB, 0u, T4K, 0u, T4K, 0u> SchedDn;
#define CP(x) ((const char*)(x))
__global__ void __launch_bounds__(512, 2) fwd_kernel(Args Araw) {
    extern __shared__ __attribute__((aligned(16))) unsigned char lds_raw[];
    LAS unsigned char* lds = (LAS unsigned char*)lds_raw;
    const int ph_hi = Araw.ph_hi; const int wave0 = __builtin_amdgcn_readfirstlane(threadIdx.x >> 6);
    volatile LAS unsigned* bst = (volatile LAS unsigned*)(lds + 131072 + 64);
    if (threadIdx.x < 2) bst[threadIdx.x] = 0u;
    __syncthreads();
    XcdBarrier xbar; xbar.bar = (unsigned*)Araw.ws; xbar.x = 0; xbar.st = bst;
    if (ph_hi - Araw.ph_lo > 1) xbar = xcd_barrier_post((unsigned*)Araw.ws, bst);
    for (int ph = Araw.ph_lo; ph < ph_hi; ++ph) {
        KArgP A = (KArgP)__builtin_amdgcn_kernarg_segment_ptr(); asm volatile("" : "+s"(A));
        unsigned char* ws = A->ws; float* hres = A->out;
        int lane, wave = wave0, bx = blockIdx.x;
        asm volatile("v_mbcnt_lo_u32_b32 %0, -1, 0\n\tv_mbcnt_hi_u32_b32 %0, -1, %0" : "=v"(lane)); asm volatile("" : "+s"(wave)); asm volatile("" : "+s"(bx));
        const int tid = wave * 64 + lane;
        const int G = gridDim.x, vcu = (G % 8 == 0) ? (bx % 8) * (G / 8) + bx / 8 : bx;
        const int gw = vcu * 8 + wave, NGW = G * 8, gtid = bx * 512 + tid, NT = G * 512;
        if (ph == 0) { if constexpr ((PHMASK >> 11) & 1) phase_convert(A, lds, gw, NGW, wave, lane, gtid, NT); }
        else if (ph == NPH - 1) { phase_norm<2>(hres, A->in[21], nullptr, hres, gw, NGW, lane); }
        else {
            const int l = (ph - 1) / NSUB, sub = (ph - 1) % NSUB;
            const bf16_t* WL = (const bf16_t*)(ws + WS_W + (size_t)l * W_LAYER_STRIDE);
            switch (sub) {
            case 0: if constexpr ((PHMASK >> 0) & 1) {
                for (int it = bx; it < 256; it += G) s5_tables(A, l, it >> 3, it & 7, lds, tid);
                if (l == 0) phase_norm<1>(A->in[0], A->in[1], XN, hres, gw, NGW, lane); else phase_norm<0>(hres, A->in[1] + (size_t)l * DM, XN, nullptr, gw, NGW, lane);
            } break;
            case 1: if constexpr ((PHMASK >> 1) & 1) {
                { SchedIn S{G, bx, CP(XN), CP(WL + W_IN)}; run_gemm(lds, S, 1024, 1024, 1024, FG1{AS5, UPOOL, Qb, Kb}); }
                { SchedVt S{G, bx, CP(WL + W_IN + (size_t)3072 * 1024), CP(XN)}; run_gemm(lds, S, 1024, 1024, 16 * 1024, FVt{VT}); }
            } break;
            case 2: if constexpr ((PHMASK >> 2) & 1) {
                { SchedS1 S{G, bx, CP(AS5), CP(W1t)}; run_gemm(lds, S, 512, AS5_PITCH, 512, FS1{SST}); }
                phase_attn(Qb, Kb, VT, Qb, vcu, G, wave, lane, lds);
            } break;
            case 3: if constexpr ((PHMASK >> 3) & 1) {
                if (wave < 2) { for (int w = bx * 2 + wave; w < 512; w += G * 2) s5_scan(A, l, w, lane); }
                phase_pool(UPOOL, POOLED, gw, NGW, lane);
            } break;
            case 4: if constexpr ((PHMASK >> 4) & 1) {
                SchedS3 S{G, bx, CP(AS5), CP(Tt)}; run_gemm(lds, S, AS5_PITCH, AS5_PITCH, AS5_PITCH, FS3{Yb});
            } break;
            case 5: if constexpr ((PHMASK >> 5) & 1) {
                SchedGlu S{G, bx, CP(Yb), CP(WL + W_GLU)}; run_gemm(lds, S, 512, 512, 512, FGlu{Yb, YS5});
            } break;
            case 6: {
                pg8::SchedBr S{G, bx, CP(XN), CP(YS5), CP(Qb), CP(WL + W_IN + (size_t)4096 * 1024), CP(WL + W_BS), CP(WL + W_BA)};
                pg8::Gemm g{1024, 1024, 1024}; pg8::EpiBr E{GT, MERGED};
                { int tid_ = tid; __builtin_amdgcn_fence(__ATOMIC_ACQUIRE, "agent"); asm volatile("" : "+v"(tid_)); pg8::gemm_phase<pg8::EpiBr, pg8::SchedBr, true, true>(lds, g, S, E, tid_); }
            } break;
            case 7: { Sched1k S{G, bx, CP(MERGED), CP(WL + W_OUT)}; run_gemm(lds, S, 1024, 1024, 1024, FResid{hres}); } break;
            case 8: { phase_norm<0>(hres, A->in[18] + (size_t)l * DM, XN, nullptr, gw, NGW, lane); } break;
            case 9: { SchedUp S{G, bx, CP(XN), CP(WL + W_UP)}; run_gemm(lds, S, 1024, 1024, 1024, FUp{HID}); } break;
            case 10: { SchedDn S{G, bx, CP(HID), CP(WL + W_DN)}; run_gemm(lds, S, 4096, 4096, 4096, FResid{hres}); } break;
            }
        }
        if (ph + 1 < ph_hi && ph != 0) {
            if (ph_hi < 0) { __threadfence(); cg::this_grid().sync(); }
            { XcdBarrier xb; xb.bar = (unsigned*)A->ws; xb.x = xb_xcc_id(); xb.st = bst; xcd_barrier(xb); }
        }
    }
}

#ifndef LAST_PH
#define LAST_PH (NPH - 1)
#endif
#ifdef DUMP_OFF
__global__ void dump_kernel(const unsigned short* src, float* dst, size_t n) { for (size_t i = (size_t)blockIdx.x * blockDim.x + threadIdx.x; i < n; i += (size_t)gridDim.x * blockDim.x) dst[i] = __uint_as_float((unsigned)src[i] << 16); }
#endif
extern "C" void kernel_launch(void* const* d_in, const int* in_sizes, int n_in, void* d_out, int out_size, void* d_ws, size_t ws_size, hipStream_t stream) {
    static int grid = 0;
    if (grid == 0) {
        if (n_in != 22 || out_size != MTOK * DM || ws_size < WS_END) { fprintf(stderr, "kernel_launch: unexpected shapes (n_in %d, out %d, ws %zu < %zu)\n", n_in, out_size, ws_size, (size_t)WS_END); grid = -1; return; }
        int dev = 0, cus = 0, per_cu = 0;
        hipGetDevice(&dev); hipDeviceGetAttribute(&cus, hipDeviceAttributeMultiprocessorCount, dev);
        if (hipFuncSetAttribute((const void*)fwd_kernel, hipFuncAttributeMaxDynamicSharedMemorySize, LDS_BYTES) != hipSuccess) { fprintf(stderr, "kernel_launch: hipFuncSetAttribute failed\n"); grid = -1; return; }
        hipOccupancyMaxActiveBlocksPerMultiprocessor(&per_cu, (const void*)fwd_kernel, 512, LDS_BYTES);
        (void)hipGetLastError();
        if (per_cu < 1) fprintf(stderr, "kernel_launch: occupancy query says %d blocks per CU\n", per_cu);
        grid = cus;
        if (grid != 256) fprintf(stderr, "kernel_launch: %d CUs (tuned for 256)\n", grid);
        while ((NB * 16 * 256) % grid != 0 || grid % 8 != 0) --grid;
    }
    if (grid < 0) return;
    (void)hipMemsetAsync(d_ws, 0, 65536, stream);
    Args a{};
    for (int i = 0; i < 22; ++i) a.in[i] = (const float*)d_in[i];
    a.out = (float*)d_out; a.ws = (unsigned char*)d_ws;
#if ONE_LAUNCH
    a.ph_lo = 0; a.ph_hi = NPH;
    void* args[] = {&a};
    hipError_t e = hipLaunchCooperativeKernel((const void*)fwd_kernel, dim3(grid), dim3(512), args, LDS_BYTES, stream);
    if (e != hipSuccess) fprintf(stderr, "cooperative launch failed: %s (grid %d)\n", hipGetErrorString(e), grid);
#else
    for (int ph = 0; ph <= LAST_PH; ++ph) { a.ph_lo = ph; a.ph_hi = ph + 1; hipLaunchKernelGGL(fwd_kernel, dim3(grid), dim3(512), LDS_BYTES, stream, a); }
#ifdef DUMP_OFF
    hipLaunchKernelGGL(dump_kernel, dim3(2048), dim3(256), 0, stream, (const unsigned short*)((const char*)d_ws + (size_t)(DUMP_OFF)), (float*)d_out, (size_t)MTOK * DM);
#endif
#endif
}
```

```cpp
#include <hip/hip_runtime.h>
#include <hip/hip_cooperative_groups.h>
#include <cstdio>
#include <cstdint>
namespace cg = cooperative_groups;

#ifndef ONE_LAUNCH
#define ONE_LAUNCH 1
#endif

#define LAS __attribute__((address_space(3)))
#define PG8_LAS __attribute__((address_space(3)))
typedef unsigned short bf16_t;
typedef short bf16x8 __attribute__((ext_vector_type(8)));
typedef float f32x4 __attribute__((ext_vector_type(4)));
typedef float f32x2 __attribute__((ext_vector_type(2)));
typedef unsigned u32x4 __attribute__((ext_vector_type(4)));
typedef unsigned u32x2 __attribute__((ext_vector_type(2)));

constexpr int NB = 8, SEQ = 4096, DM = 1024, MTOK = NB * SEQ, DFF = 4096, NLAYER = 2;
constexpr float NORM_EPS = 1e-6f;
constexpr float LOG2E = 1.4426950408889634f;
constexpr float QSCALE = 0.125f * LOG2E;
constexpr int LC = 32;
constexpr int AS5_PITCH = 768;

constexpr size_t MiB = (size_t)1 << 20;
constexpr size_t WS_W = 1 * MiB, W_LAYER_STRIDE = 37 * MiB;
constexpr size_t W_IN = 0, W_GLU = 7340032, W_BS = 7602176, W_BP = 8126464, W_BA = 8650752, W_OUT = 9699328, W_UP = 10747904, W_DN = 14942208;
constexpr size_t WS_T = 75 * MiB, WS_W1 = 99 * MiB, WS_XN = 107 * MiB, WS_UPOOL = 171 * MiB, WS_AS5 = 203 * MiB, WS_Q = 251 * MiB, WS_K = 315 * MiB, WS_VT = 379 * MiB,
                 WS_SST = 443 * MiB, WS_END = 475 * MiB;
constexpr size_t WS_POOLED = WS_K, WS_YS5 = WS_K  , WS_GT = WS_VT, WS_MERGED = WS_UPOOL, WS_Y = WS_SST, WS_HID = WS_UPOOL;
constexpr int LDS_BYTES = 135168;

struct Args { const float* in[22]; float* out; unsigned char* ws; int ph_lo, ph_hi; };
typedef const __attribute__((address_space(4))) Args* KArgP;

typedef __bf16 bf16x2_t __attribute__((ext_vector_type(2)));
__device__ __forceinline__ unsigned cvt_pk_bf16(float lo, float hi) { const f32x2 v = {lo, hi}; const bf16x2_t b = __builtin_convertvector(v, bf16x2_t); return __builtin_bit_cast(unsigned, b); }
__device__ __forceinline__ u32x4 pack8(f32x4 a, f32x4 b) { u32x4 w; w.x = cvt_pk_bf16(a[0], a[1]); w.y = cvt_pk_bf16(a[2], a[3]); w.z = cvt_pk_bf16(b[0], b[1]); w.w = cvt_pk_bf16(b[2], b[3]); return w; }
__device__ __forceinline__ float bf_lo(unsigned w) { return __uint_as_float(w << 16); }
__device__ __forceinline__ float bf_hi(unsigned w) { return __uint_as_float(w & 0xffff0000u); }
__device__ __forceinline__ void unpack8(u32x4 w, f32x4& a, f32x4& b) { a = (f32x4){bf_lo(w.x), bf_hi(w.x), bf_lo(w.y), bf_hi(w.y)}; b = (f32x4){bf_lo(w.z), bf_hi(w.z), bf_lo(w.w), bf_hi(w.w)}; }
__device__ __forceinline__ float fast_sigmoid(float x) { return __builtin_amdgcn_rcpf(1.0f + __builtin_amdgcn_exp2f(-LOG2E * x)); }
__device__ __forceinline__ f32x4 sig4(f32x4 v) { return (f32x4){fast_sigmoid(v[0]), fast_sigmoid(v[1]), fast_sigmoid(v[2]), fast_sigmoid(v[3])}; }
__device__ __forceinline__ float gelu_tanh(float y) { const float u = 0.7978845608028654f * (y + 0.044715f * y * y * y); return y * fast_sigmoid(2.0f * u); }
__device__ __forceinline__ f32x4 gelu4(f32x4 v) { return (f32x4){gelu_tanh(v[0]), gelu_tanh(v[1]), gelu_tanh(v[2]), gelu_tanh(v[3])}; }
__device__ __forceinline__ float shx(float v, int o, int lane) { return __int_as_float(__builtin_amdgcn_ds_bpermute((lane ^ o) << 2, __float_as_int(v))); }
__device__ __forceinline__ float wave_sum(float v, int lane) {
#pragma unroll
    for (int o = 1; o < 64; o <<= 1) v += shx(v, o, lane);
    return v;
}

namespace pg8 {
constexpr int BM = 256, BK = 64, HALF = 128, HTB = HALF * BK * 2, STAGE_BYTES = 8 * HTB, NXCD = 8, WGM = 8;
__host__ __device__ __forceinline__ int lds_byte(int r, int c) { const int st = (r >> 4) * 2 + (c >> 5), rr = r & 15, cc = c & 31, ob = rr * 64 + cc * 2; return st * 1024 + (ob ^ (((ob >> 9) & 1) << 5)); }
__host__ __device__ __forceinline__ void stage_rc(int b, int& R, int& C) { const int st = b / 1024, sb = b % 1024, swz = sb ^ (((sb >> 9) & 1) << 5); R = (st >> 1) * 16 + swz / 64; C = (st & 1) * 32 + (swz % 64) / 2; }
__host__ __device__ __forceinline__ int perm32(int rho) { const int n = rho >> 4, i = rho & 15; return 8 * (i >> 2) + 4 * n + (i & 3); }

struct Unit { int pm, pn; const char* a; const char* b; int nt, kind; };
struct Gemm { int K, lda, ldb; };

template <int NM, int NN, int NMZ, int BDIV, unsigned AZ, unsigned AT, unsigned BZ, unsigned BLO, unsigned BHI>
struct SchedT {
    int G, c; const char* A; const char* B;
    __device__ __forceinline__ bool next(int i, Unit& u) const {
        constexpr int nwg = NM * NN;
        const int L = i * G + c; if (L >= nwg) return false;
        int wgid = L; { constexpr int q = nwg / NXCD, r = nwg % NXCD; const int xcd = wgid % NXCD, off = wgid / NXCD; wgid = (xcd < r ? xcd * (q + 1) : r * (q + 1) + (xcd - r) * q) + off; }
        constexpr int nig = WGM * NN; const int gid = wgid / nig, fm = gid * WGM, gsz = (NM - fm) < WGM ? (NM - fm) : WGM;
        u.pm = fm + ((wgid % nig) % gsz); u.pn = (wgid % nig) / gsz;
        const int z = u.pm / NMZ, pmz = u.pm - z * NMZ;
        u.a = A + (size_t)z * AZ + (size_t)pmz * AT;
        u.b = B + (size_t)z * BZ + (size_t)(u.pn / BDIV) * BHI + (size_t)(u.pn % BDIV) * BLO; u.nt = 0; u.kind = 0;
        return true;
    }
    __device__ __forceinline__ void a_ready(const Unit&) const {}
    __device__ __forceinline__ void done(const Unit&) const {}
};

struct EpiBuf { u32x4 a, b; };
template <class F> struct EpiT {
    static constexpr bool PERM = true, AFTER_DRAIN = false; F f;
    __device__ __forceinline__ void operator()(const f32x4 (&acc)[2][2][4][2], const Unit& u, int wr, int wc, int fr, int fq) const {
#pragma unroll
        for (int ai = 0; ai < 2; ++ai) {
            EpiBuf buf[4][2];
            if constexpr (F::NLOAD > 0) {
#pragma unroll
                for (int m = 0; m < 4; ++m)
#pragma unroll
                    for (int bj = 0; bj < 2; ++bj) f.load(u.pm * BM + ai * HALF + wr * 64 + m * 16 + fr, u.pn * BM + bj * HALF + wc * 32 + 8 * fq, buf[m][bj]);
            }
#pragma unroll
            for (int m = 0; m < 4; ++m)
#pragma unroll
                for (int bj = 0; bj < 2; ++bj) f.apply(u.pm * BM + ai * HALF + wr * 64 + m * 16 + fr, u.pn * BM + bj * HALF + wc * 32 + 8 * fq, acc[ai][bj][m][0], acc[ai][bj][m][1], buf[m][bj]);
            asm volatile("" ::: "memory");
        }
    }
    __device__ __forceinline__ void fused(f32x4 (&)[2][2][4][2], const Unit&, int, int, int, int, PG8_LAS unsigned char*, int, int) const {}
};

struct SchedBr {
    int G, c; const char* xn; const char* sp; const char* ya; const char* wgate; const char* wsp; const char* wba;
    __device__ __forceinline__ bool next(int i, Unit& u) const {
        constexpr int NM = 128, NN = 4, nwg = NM * NN; const int tile = i / 6, kind = i - 6 * tile;
        const int L = tile * G + c; if (L >= nwg) return false;
        int wgid = L; { constexpr int q = nwg / NXCD; const int xcd = wgid % NXCD, off = wgid / NXCD; wgid = xcd * q + off; }
        constexpr int nig = WGM * NN; const int gid = wgid / nig, fm = gid * WGM;
        u.pm = fm + ((wgid % nig) % WGM); u.pn = (wgid % nig) / WGM; u.kind = kind;
        const size_t ta = (size_t)u.pm * (256u * 1024 * 2), tb = (size_t)u.pn * (256u * 1024 * 2);
        if ((kind & 1) == 0) { u.a = xn + ta; u.b = wgate + (size_t)(kind >> 1) * (1024u * 1024 * 2) + tb; u.nt = 16; }
        else if (kind == 1) { u.a = sp + ta; u.b = wsp + tb; u.nt = 8; }
        else if (kind == 3) { u.a = sp + ta + 1024; u.b = wsp + tb + 1024; u.nt = 8; }
        else { u.a = ya + ta; u.b = wba + tb; u.nt = 16; }
        return true;
    }
    __device__ __forceinline__ void a_ready(const Unit&) const {}
    __device__ __forceinline__ void done(const Unit&) const {}
};
struct EpiBr {
    static constexpr bool PERM = true, AFTER_DRAIN = false; bf16_t* gt; bf16_t* mg;
    __device__ __forceinline__ void operator()(const f32x4 (&acc)[2][2][4][2], const Unit& u, int wr, int wc, int fr, int fq) const {
        const int kind = u.kind;
#pragma unroll
        for (int ai = 0; ai < 2; ++ai) {
            if (kind & 1) {
                EpiBuf buf[4][2];
#pragma unroll
                for (int m = 0; m < 4; ++m)
#pragma unroll
                    for (int bj = 0; bj < 2; ++bj) { const size_t o = (size_t)(u.pm * BM + ai * HALF + wr * 64 + m * 16 + fr) * 1024 + u.pn * BM + bj * HALF + wc * 32 + 8 * fq;
                        buf[m][bj].a = *(const u32x4*)(gt + o); if (kind > 1) buf[m][bj].b = *(const u32x4*)(mg + o); }
#pragma unroll
                for (int m = 0; m < 4; ++m)
#pragma unroll
                    for (int bj = 0; bj < 2; ++bj) { const size_t o = (size_t)(u.pm * BM + ai * HALF + wr * 64 + m * 16 + fr) * 1024 + u.pn * BM + bj * HALF + wc * 32 + 8 * fq;
                        f32x4 ga, gb; unpack8(buf[m][bj].a, ga, gb); f32x4 va = ga * acc[ai][bj][m][0], vb = gb * acc[ai][bj][m][1];
                        if (kind > 1) { f32x4 ma, mb; unpack8(buf[m][bj].b, ma, mb); va += ma; vb += mb; }
                        *(u32x4*)(mg + o) = pack8(va, vb); }
            } else {
#pragma unroll
                for (int m = 0; m < 4; ++m)
#pragma unroll
                    for (int bj = 0; bj < 2; ++bj) { const size_t o = (size_t)(u.pm * BM + ai * HALF + wr * 64 + m * 16 + fr) * 1024 + u.pn * BM + bj * HALF + wc * 32 + 8 * fq;
                        *(u32x4*)(gt + o) = pack8(sig4(acc[ai][bj][m][0]), sig4(acc[ai][bj][m][1])); }
            }
            asm volatile("" ::: "memory");
        }
    }
    __device__ __forceinline__ void fused(f32x4 (&)[2][2][4][2], const Unit&, int, int, int, int, PG8_LAS unsigned char*, int, int) const {}
};

template <class Epi, class Sched, bool ALIGN_EPI = false, bool SP2 = false>
__device__ __forceinline__ void gemm_phase(PG8_LAS unsigned char* lds, const Gemm g, const Sched& S, const Epi& E, const int tid) {
    const int  wid = __builtin_amdgcn_readfirstlane(tid >> 6), lane = tid & 63, wr = wid >> 2, wc = wid & 3, fr = lane & 15, fq = lane >> 4;
    const int K = g.K, nt = K / BK;
    unsigned voffA[2], voffB[2];
#pragma unroll
    for (int i = 0; i < 2; ++i) { int R, C; stage_rc(tid * 16 + i * 8192, R, C); const int Rb = Epi::PERM ? ((R & ~31) + perm32(R & 31)) : R;
        voffA[i] = (unsigned)(R * g.lda + C) * 2u; voffB[i] = (unsigned)(Rb * g.ldb + C) * 2u; }
    const size_t kstep = (size_t)(BK * 2);
    const size_t hstepA = (size_t)HALF * g.lda * 2, hstepB = (size_t)HALF * g.ldb * 2;
    const unsigned ldsw = (unsigned)wid * 1024u;
    const int aoff = lds_byte(wr * 64 + fr, fq * 8), boff = lds_byte(wc * 32 + fr, fq * 8);
#define PG8_SA(b, h) (((b) * 2 + (h)) * HTB)
#define PG8_SB(b, h) ((4 + (b) * 2 + (h)) * HTB)
#define PG8_STAGE(bufoff, gbase, voff) do { _Pragma("unroll") for (int _i = 0; _i < 2; ++_i) \
        __builtin_amdgcn_global_load_lds((const unsigned*)((const char*)(gbase) + (voff)[_i]), (PG8_LAS unsigned*)(lds + (bufoff) + ldsw + _i * 8192), 16, 0, 0); } while (0)
#define PG8_LDA(dst, b, h) do { _Pragma("unroll") for (int m = 0; m < 4; ++m) _Pragma("unroll") for (int k = 0; k < 2; ++k) dst[m][k] = *(const PG8_LAS bf16x8*)(lds + PG8_SA(b, h) + aoff + m * 2048 + k * 1024); } while (0)
#define PG8_LDB(dst, b, h) do { _Pragma("unroll") for (int n = 0; n < 2; ++n) _Pragma("unroll") for (int k = 0; k < 2; ++k) dst[n][k] = *(const PG8_LAS bf16x8*)(lds + PG8_SB(b, h) + boff + n * 2048 + k * 1024); } while (0)
#define PG8_MMA(ai, bj, At, Bt) do { __builtin_amdgcn_s_setprio(1); _Pragma("unroll") for (int m = 0; m < 4; ++m) _Pragma("unroll") for (int n = 0; n < 2; ++n) _Pragma("unroll") for (int k = 0; k < 2; ++k) \
        acc[ai][bj][m][n] = __builtin_amdgcn_mfma_f32_16x16x32_bf16(Bt[n][k], At[m][k], acc[ai][bj][m][n], 0, 0, 0); __builtin_amdgcn_s_setprio(0); } while (0)
#define PG8_WAIT_V(n) asm volatile("s_waitcnt vmcnt(" #n ")" ::: "memory")
#define PG8_WAIT_L(n) asm volatile("s_waitcnt lgkmcnt(" #n ")" ::: "memory")
#define PG8_BAR __builtin_amdgcn_s_barrier()
#define PG8_SCHED __builtin_amdgcn_sched_barrier(0)
    Unit cur, nxt; int ui = 0;
    if (!S.next(0, cur)) return;
    f32x4 acc[2][2][4][2];
#pragma unroll
    for (int a = 0; a < 2; ++a)
#pragma unroll
        for (int b = 0; b < 2; ++b)
#pragma unroll
            for (int m = 0; m < 4; ++m)
#pragma unroll
                for (int n = 0; n < 2; ++n) acc[a][b][m][n] = (f32x4){0.f, 0.f, 0.f, 0.f};
    bf16x8 At[4][2], B0[2][2], B1[2][2];
    const char* cA = cur.a; const char* cB = cur.b;
    S.a_ready(cur);
    if constexpr (SP2) {
        PG8_STAGE(PG8_SB(0, 0), cB, voffB); PG8_STAGE(PG8_SB(0, 1), cB + hstepB, voffB); PG8_STAGE(PG8_SA(0, 0), cA, voffA); PG8_STAGE(PG8_SA(0, 1), cA + hstepA, voffA);
        if (wr == 1) PG8_BAR;
        PG8_WAIT_V(2); PG8_BAR;
        PG8_STAGE(PG8_SB(1, 0), cB + kstep, voffB); PG8_STAGE(PG8_SA(1, 0), cA + kstep, voffA); PG8_STAGE(PG8_SB(1, 1), cB + hstepB + kstep, voffB);
        PG8_WAIT_V(6); PG8_BAR;
    } else {
        PG8_STAGE(PG8_SB(0, 0), cB, voffB); PG8_STAGE(PG8_SA(0, 0), cA, voffA); PG8_STAGE(PG8_SB(0, 1), cB + hstepB, voffB); PG8_STAGE(PG8_SA(0, 1), cA + hstepA, voffA);
        if (wr == 1) PG8_BAR;
        PG8_WAIT_V(4); PG8_BAR;
        PG8_STAGE(PG8_SB(1, 0), cB + kstep, voffB); PG8_STAGE(PG8_SA(1, 0), cA + kstep, voffA); PG8_STAGE(PG8_SB(1, 1), cB + hstepB + kstep, voffB);
        PG8_WAIT_V(6); PG8_BAR;
    }
    for (;;) {
        const bool has_next = S.next(ui + 1, nxt);
        const char* nA = has_next ? nxt.a : cA; const char* nB = has_next ? nxt.b : cB;
        const int nt_u = cur.nt > 0 ? cur.nt : nt;
        for (int t = 0; t < nt_u; t += 2) {
            const bool last = (t == nt_u - 2);
            const char* a1 = cA + (size_t)(t + 1) * kstep;
            const char* a2 = last ? nA : cA + (size_t)(t + 2) * kstep; const char* b2 = last ? nB : cB + (size_t)(t + 2) * kstep;
            const char* a3 = a2 + kstep; const char* b3 = b2 + kstep;
            if (last && has_next) S.a_ready(nxt);
            if constexpr (SP2) {
            PG8_LDB(B0, 0, 0); PG8_LDB(B1, 0, 1); PG8_SCHED; PG8_LDA(At, 0, 0); PG8_STAGE(PG8_SA(1, 1), a1 + hstepA, voffA);
            PG8_WAIT_V(8); PG8_WAIT_L(0); PG8_BAR; PG8_MMA(0, 0, At, B0); PG8_MMA(0, 1, At, B1); PG8_BAR; PG8_SCHED;
            PG8_LDA(At, 0, 1); PG8_STAGE(PG8_SB(0, 0), b2, voffB); PG8_STAGE(PG8_SB(0, 1), b2 + hstepB, voffB); PG8_STAGE(PG8_SA(0, 0), a2, voffA);
            PG8_WAIT_V(8); PG8_WAIT_L(0); PG8_BAR; PG8_MMA(1, 0, At, B0); PG8_MMA(1, 1, At, B1); PG8_BAR; PG8_SCHED;
            PG8_LDB(B0, 1, 0); PG8_LDB(B1, 1, 1); PG8_SCHED; PG8_LDA(At, 1, 0); PG8_STAGE(PG8_SA(0, 1), a2 + hstepA, voffA);
            PG8_WAIT_V(8); PG8_WAIT_L(0); PG8_BAR; PG8_MMA(0, 0, At, B0); PG8_MMA(0, 1, At, B1); PG8_BAR; PG8_SCHED;
            PG8_LDA(At, 1, 1); PG8_STAGE(PG8_SB(1, 0), b3, voffB); PG8_STAGE(PG8_SB(1, 1), b3 + hstepB, voffB); PG8_STAGE(PG8_SA(1, 0), a3, voffA);
            PG8_WAIT_V(8); PG8_WAIT_L(0); PG8_BAR; PG8_MMA(1, 0, At, B0); PG8_MMA(1, 1, At, B1); PG8_BAR; PG8_SCHED;
            } else {
            PG8_LDB(B0, 0, 0); PG8_SCHED; PG8_LDA(At, 0, 0); PG8_STAGE(PG8_SA(1, 1), a1 + hstepA, voffA);
            PG8_WAIT_L(8); PG8_BAR; PG8_WAIT_L(0); PG8_MMA(0, 0, At, B0); PG8_BAR; PG8_SCHED;
            PG8_LDB(B1, 0, 1); PG8_STAGE(PG8_SB(0, 0), b2, voffB);
            PG8_BAR; PG8_WAIT_L(0); PG8_MMA(0, 1, At, B1); PG8_BAR;
            PG8_LDA(At, 0, 1); PG8_STAGE(PG8_SA(0, 0), a2, voffA);
            PG8_BAR; PG8_WAIT_L(0); PG8_MMA(1, 0, At, B0); PG8_BAR; PG8_SCHED;
            PG8_STAGE(PG8_SB(0, 1), b2 + hstepB, voffB);
            PG8_WAIT_V(6); PG8_BAR; PG8_MMA(1, 1, At, B1); PG8_BAR;
            PG8_LDB(B0, 1, 0); PG8_SCHED; PG8_LDA(At, 1, 0); PG8_STAGE(PG8_SA(0, 1), a2 + hstepA, voffA);
            PG8_WAIT_L(8); PG8_BAR; PG8_WAIT_L(0); PG8_MMA(0, 0, At, B0); PG8_BAR; PG8_SCHED;
            PG8_LDB(B1, 1, 1); PG8_STAGE(PG8_SB(1, 0), b3, voffB);
            PG8_BAR; PG8_WAIT_L(0); PG8_MMA(0, 1, At, B1); PG8_BAR;
            PG8_LDA(At, 1, 1); PG8_STAGE(PG8_SA(1, 0), a3, voffA);
            PG8_BAR; PG8_WAIT_L(0); PG8_MMA(1, 0, At, B0); PG8_BAR; PG8_SCHED;
            PG8_STAGE(PG8_SB(1, 1), b3 + hstepB, voffB);
            PG8_WAIT_V(6); PG8_BAR; PG8_MMA(1, 1, At, B1); PG8_BAR;
            }
        }
        if constexpr (ALIGN_EPI) { if (wr == 0) PG8_BAR; }
        if constexpr (!Epi::AFTER_DRAIN) { E(acc, cur, wr, wc, fr, fq); S.done(cur); }
        if (!has_next) break;
#pragma unroll
        for (int a = 0; a < 2; ++a)
#pragma unroll
            for (int b = 0; b < 2; ++b)
#pragma unroll
                for (int m = 0; m < 4; ++m)
#pragma unroll
                    for (int n = 0; n < 2; ++n) acc[a][b][m][n] = (f32x4){0.f, 0.f, 0.f, 0.f};
        cur = nxt; cA = nA; cB = nB; ++ui;
        if constexpr (ALIGN_EPI) { if (wr == 1) PG8_BAR; }
    }
    PG8_WAIT_V(0);
    if constexpr (!ALIGN_EPI) { if (wr == 0) PG8_BAR; }
    PG8_BAR;
    if constexpr (Epi::AFTER_DRAIN) { E.fused(acc, cur, wr, wc, fr, fq, lds, wid, lane); S.done(cur); }
#undef PG8_SA
#undef PG8_SB
#undef PG8_STAGE
#undef PG8_LDA
#undef PG8_LDB
#undef PG8_MMA
#undef PG8_WAIT_V
#undef PG8_WAIT_L
#undef PG8_BAR
#undef PG8_SCHED
}
}

struct FG1 { static constexpr int NLOAD = 0;
    bf16_t *as5, *upool, *q, *k;
    __device__ __forceinline__ void apply(int row, int col, f32x4 a, f32x4 b, const pg8::EpiBuf& lb) const {
        if (col < 512) { const int g = col >> 4, q0 = col & 15, bb = row >> 12, t = row & 4095, c = t >> 5, i = t & 31;
            *(u32x4*)(as5 + ((size_t)(g * 1024 + bb * 128 + c) * AS5_PITCH + i * 16 + q0)) = pack8(a, b); }
        else if (col < 1024) *(u32x4*)(upool + (size_t)row * 512 + (col - 512)) = pack8(a, b);
        else if (col < 2048) *(u32x4*)(q + (size_t)row * 1024 + (col - 1024)) = pack8(a * QSCALE, b * QSCALE);
        else { const int hd = col - 2048, h = hd >> 6, d0 = hd & 63, bb = row >> 12, t = row & 4095;
            *(u32x4*)(k + ((size_t)(((bb * 16 + h) * 16 + (t & 15)) * 256 + (t >> 4)) * 64 + d0)) = pack8(a, b); }
    }
};
struct FPlain { static constexpr int NLOAD = 0; bf16_t* o; int ldc; __device__ __forceinline__ void apply(int row, int col, f32x4 a, f32x4 b, const pg8::EpiBuf& lb) const { *(u32x4*)(o + (size_t)row * ldc + col) = pack8(a, b); } };
struct FVt { static constexpr int NLOAD = 0;
    bf16_t* v;
    __device__ __forceinline__ void apply(int row, int col, f32x4 a, f32x4 b, const pg8::EpiBuf& lb) const {
        const int h = row >> 6, d = row & 63, bb = col >> 12, rho = (col >> 8) & 15, i = col & 255;
        bf16_t* p = v + ((size_t)((((bb * 16 + h) * 16 + rho) * 64 + (i >> 2)) * 64 + d)) * 4;
        u32x2 w0, w1; w0.x = cvt_pk_bf16(a[0], a[1]); w0.y = cvt_pk_bf16(a[2], a[3]); w1.x = cvt_pk_bf16(b[0], b[1]); w1.y = cvt_pk_bf16(b[2], b[3]);
        *(u32x2*)p = w0; *(u32x2*)(p + 256) = w1; }
};
struct FS1 { static constexpr int NLOAD = 0; float* s; __device__ __forceinline__ void apply(int row, int col, f32x4 a, f32x4 b, const pg8::EpiBuf& lb) const { f32x4* p = (f32x4*)(s + (size_t)row * 256 + col); p[0] = a; p[1] = b; } };
struct FS3 { static constexpr int NLOAD = 0;
    bf16_t* y;
    __device__ __forceinline__ void apply(int row, int col, f32x4 a, f32x4 b, const pg8::EpiBuf& lb) const {
        const int g = row >> 10, bc = row & 1023, bb = bc >> 7, c = bc & 127, j = col >> 4, p0 = col & 15;
        const size_t tok = (size_t)bb * 4096 + c * 32 + j;
        *(u32x4*)(y + tok * 512 + g * 16 + p0) = pack8(gelu4(a), gelu4(b)); }
};
struct FGlu { static constexpr int NLOAD = 1; const bf16_t* y; bf16_t* o;
    __device__ __forceinline__ void load(int row, int col, pg8::EpiBuf& lb) const { lb.a = *(const u32x4*)(y + (size_t)row * 512 + col); }
    __device__ __forceinline__ void apply(int row, int col, f32x4 a, f32x4 b, const pg8::EpiBuf& lb) const {
        f32x4 ya, yb; unpack8(lb.a, ya, yb);
        *(u32x4*)(o + (size_t)row * 1024 + col) = pack8(ya * sig4(a), yb * sig4(b)); }
};
struct FGate { static constexpr int NLOAD = 0; bf16_t* gt; __device__ __forceinline__ void apply(int row, int col, f32x4 a, f32x4 b, const pg8::EpiBuf& lb) const { *(u32x4*)(gt + (size_t)row * 1024 + col) = pack8(sig4(a), sig4(b)); } };
template <int MODE> struct FBranch { static constexpr int NLOAD = 2; const bf16_t* gt; bf16_t* mg;
    __device__ __forceinline__ void load(int row, int col, pg8::EpiBuf& lb) const { const size_t o = (size_t)row * 1024 + col; lb.a = *(const u32x4*)(gt + o); if (MODE) lb.b = *(const u32x4*)(mg + o); }
    __device__ __forceinline__ void apply(int row, int col, f32x4 a, f32x4 b, const pg8::EpiBuf& lb) const {
        const size_t o = (size_t)row * 1024 + col; f32x4 ga, gb; unpack8(lb.a, ga, gb);
        f32x4 va = ga * a, vb = gb * b;
        if (MODE) { f32x4 ma, mb; unpack8(lb.b, ma, mb); va += ma; vb += mb; }
        *(u32x4*)(mg + o) = pack8(va, vb); }
};
struct FResid { static constexpr int NLOAD = 2; float* h;
    __device__ __forceinline__ void load(int row, int col, pg8::EpiBuf& lb) const { const u32x4* p = (const u32x4*)(h + (size_t)row * 1024 + col); lb.a = p[0]; lb.b = p[1]; }
    __device__ __forceinline__ void apply(int row, int col, f32x4 a, f32x4 b, const pg8::EpiBuf& lb) const {
        f32x4* p = (f32x4*)(h + (size_t)row * 1024 + col); p[0] = __builtin_bit_cast(f32x4, lb.a) + a; p[1] = __builtin_bit_cast(f32x4, lb.b) + b; }
};
struct FUp { static constexpr int NLOAD = 0; bf16_t* hid;
    __device__ __forceinline__ void apply(int row, int col, f32x4 a, f32x4 b, const pg8::EpiBuf& lb) const {
        f32x4 ra, rb;
#pragma unroll
        for (int i = 0; i < 4; ++i) { const float x = fmaxf(a[i], 0.f), y = fmaxf(b[i], 0.f); ra[i] = x * x; rb[i] = y * y; }
        *(u32x4*)(hid + (size_t)row * 4096 + col) = pack8(ra, rb); }
};

template <class SC, class F> __device__ __forceinline__ void run_gemm_(LAS unsigned char* lds, const SC& S, int K, int lda, int ldb, const F& f, int tid) {
    __builtin_amdgcn_fence(__ATOMIC_ACQUIRE, "agent");
    asm volatile("" : "+v"(tid));
    pg8::Gemm g{K, lda, ldb}; pg8::EpiT<F> E{f};
    pg8::gemm_phase<pg8::EpiT<F>, SC, true, true>(lds, g, S, E, tid);
}

__device__ __forceinline__ unsigned f2bf(float f) { unsigned u = __builtin_bit_cast(unsigned, f); return (u + 0x7fffu + ((u >> 16) & 1u)) >> 16; }
__device__ __forceinline__ unsigned pk2(float lo, float hi) { return f2bf(lo) | (f2bf(hi) << 16); }
__device__ __forceinline__ void transpose_item(const float* W, int K, int N, bf16_t* WT, int pitch, LAS float* scr, int item, int lane) {
    const int nblk = N / 32, kb = item / nblk, nb = item % nblk, k0 = 64 * kb, n0 = 32 * nb;
    float wv[32];
#pragma unroll
    for (int i = 0; i < 32; ++i) wv[i] = W[(size_t)(k0 + 2 * i + (lane >> 5)) * N + n0 + (lane & 31)];
#pragma unroll
    for (int i = 0; i < 32; ++i) scr[(2 * i + (lane >> 5)) * 33 + (lane & 31)] = wv[i];
    asm volatile("s_waitcnt lgkmcnt(0)" ::: "memory");
    const int c = lane & 7;
#pragma unroll
    for (int j = 0; j < 4; ++j) { const int n = (lane >> 3) + 8 * j; const LAS float* s = scr + (8 * c) * 33 + n;
        u32x4 o; o.x = pk2(s[0 * 33], s[1 * 33]); o.y = pk2(s[2 * 33], s[3 * 33]); o.z = pk2(s[4 * 33], s[5 * 33]); o.w = pk2(s[6 * 33], s[7 * 33]);
        *(u32x4*)(WT + (size_t)(n0 + n) * pitch + k0 + 8 * c) = o; }
    asm volatile("s_waitcnt lgkmcnt(0)" ::: "memory");
}
__device__ __forceinline__ void phase_convert(KArgP A, LAS unsigned char* lds, int gw, int NGW, int wave, int lane, int gtid, int NT) {
    LAS float* scr = (LAS float*)(lds + wave * 16384);
    for (int l = 0; l < NLAYER; ++l) {
        bf16_t* WL = (bf16_t*)(A->ws + WS_W + (size_t)l * W_LAYER_STRIDE);
        const float* srcs[7] = {A->in[2] + (size_t)l * 1024 * 7168, A->in[11] + (size_t)l * 512 * 512, A->in[14] + (size_t)l * 512 * 1024, A->in[16] + (size_t)l * 1024 * 1024,
                                A->in[17] + (size_t)l * 1024 * 1024, A->in[19] + (size_t)l * 1024 * 4096, A->in[20] + (size_t)l * 4096 * 1024};
        const int Ks[7] = {1024, 512, 512, 1024, 1024, 1024, 4096}, Ns[7] = {7168, 512, 1024, 1024, 1024, 4096, 1024};
        const size_t offs[7] = {W_IN, W_GLU, W_BS, W_BA, W_OUT, W_UP, W_DN};
#pragma unroll
        for (int w = 0; w < 7; ++w) { const int items = (Ks[w] / 64) * (Ns[w] / 32);
            const int pitch = (w == 2) ? 1024 : Ks[w];
            for (int it = gw; it < items; it += NGW) transpose_item(srcs[w], Ks[w], Ns[w], WL + offs[w], pitch, scr, it, lane); }
        const float* pw = A->in[12] + (size_t)l * 4 * 128 * 128; const float* psc = A->in[13] + (size_t)l * 512; const float* wbp = A->in[15] + (size_t)l * 512 * 1024;
        bf16_t* WP = WL + W_BS + 512;
        for (int e = gtid; e < 1024 * 512; e += NT) { const int k = __builtin_amdgcn_readfirstlane(e >> 10), n = e & 1023, g = k >> 7;
            const float* pr = pw + (size_t)k * 128; const float* sc = psc + g * 128; const float* wb = wbp + (size_t)(g * 128) * 1024 + n; float acc = 0.f;
#pragma unroll 8
            for (int d = 0; d < 128; ++d) acc += (pr[d] * sc[d]) * wb[(size_t)d * 1024];
            WP[(size_t)n * 1024 + k] = (bf16_t)f2bf(acc); }
    }
}

template <int MODE  >
__device__ __forceinline__ void phase_norm(const float* src, const float* gain, bf16_t* xn, float* dst, int gw, int NGW, int lane) {
    f32x4 gv[4];
#pragma unroll
    for (int j = 0; j < 4; ++j) gv[j] = *((const f32x4*)gain + lane + 64 * j);
    for (int m = gw; m < MTOK; m += NGW) {
        const f32x4* xr = (const f32x4*)(src + (size_t)m * DM) + lane; f32x4 v[4]; float s = 0.f;
#pragma unroll
        for (int j = 0; j < 4; ++j) { v[j] = xr[64 * j]; s += (v[j].x * v[j].x + v[j].y * v[j].y) + (v[j].z * v[j].z + v[j].w * v[j].w); }
        const float r = 1.0f / sqrtf(wave_sum(s, lane) * (1.0f / DM) + NORM_EPS);
        if (MODE == 1) { f32x4* o = (f32x4*)(dst + (size_t)m * DM) + lane;
#pragma unroll
            for (int j = 0; j < 4; ++j) o[64 * j] = v[j]; }
        if (MODE == 2) { f32x4* o = (f32x4*)(dst + (size_t)m * DM) + lane;
#pragma unroll
            for (int j = 0; j < 4; ++j) o[64 * j] = v[j] * r * gv[j]; }
        else { u32x2* o = (u32x2*)(xn + (size_t)m * DM) + lane;
#pragma unroll
            for (int j = 0; j < 4; ++j) { const f32x4 y = v[j] * r * gv[j]; u32x2 w; w.x = cvt_pk_bf16(y.x, y.y); w.y = cvt_pk_bf16(y.z, y.w); o[64 * j] = w; } }
    }
}

__device__ __forceinline__ void sincos_d(double ang, double& s, double& c) {
    const double x = ang * 0.63661977236758134308; const double q = rint(x); const float y = (float)((x - q) * 1.57079632679489661923); const float y2 = y * y;
    const float sp = y * (1.0f + y2 * (-1.0f / 6 + y2 * (1.0f / 120 + y2 * (-1.0f / 5040 + y2 * (1.0f / 362880)))));
    const float cp = 1.0f + y2 * (-0.5f + y2 * (1.0f / 24 + y2 * (-1.0f / 720 + y2 * (1.0f / 40320 + y2 * (-1.0f / 3628800)))));
    const int qi = ((int)q) & 3;
    s = (double)((qi == 0) ? sp : (qi == 1) ? cp : (qi == 2) ? -sp : -cp);
    c = (double)((qi == 0) ? cp : (qi == 1) ? -sp : (qi == 2) ? -cp : sp);
}
__device__ __forceinline__ void a_pow(float lr, float li, float dt, int d, float& re, float& im) {
    const float mag = expf(lr * dt * (float)d); double s, c; sincos_d((double)li * (double)dt * (double)d, s, c); re = mag * (float)c; im = mag * (float)s;
}
__device__ __forceinline__ void s5_tables(KArgP A, int l, int g, int ps, LAS unsigned char* lds, int tid) {
    LAS f32x2* pw = (LAS f32x2*)lds;
    LAS f32x2* Bb = (LAS f32x2*)(lds + 33792);
    LAS float* Kt = (LAS float*)(lds + 50176);
    const float* lam_re = A->in[3]; const float* lam_im = A->in[4]; const float* log_dt = A->in[5];
    const float* b_re = A->in[6]; const float* b_im = A->in[7]; const float* c_re = A->in[8]; const float* c_im = A->in[9]; const float* dsk = A->in[10];
    for (int e = tid; e < 2 * 33 * 64; e += 512) { const int dir = e / (33 * 64), rem = e - dir * 33 * 64, d = rem >> 6, n = rem & 63; const int gi = (l * 2 + dir) * 32 + g;
        float re, im; a_pow(lam_re[gi * 64 + n], lam_im[gi * 64 + n], expf(log_dt[gi]), d, re, im); pw[e] = (f32x2){re, im}; }
    for (int e = tid; e < 2 * 64 * 16; e += 512) { const int dir = e >> 10, n = (e >> 4) & 63, q = e & 15; const int gi = (l * 2 + dir) * 32 + g;
        const float lr = lam_re[gi * 64 + n], li = lam_im[gi * 64 + n]; float ar, ai; a_pow(lr, li, expf(log_dt[gi]), 1, ar, ai);
        const double nr = (double)ar - 1.0, ni = (double)ai, den = (double)lr * lr + (double)li * li; const double cr = (nr * lr + ni * li) / den, ci = (ni * lr - nr * li) / den;
        const float br = b_re[((size_t)gi * 64 + n) * 16 + q], bi = b_im[((size_t)gi * 64 + n) * 16 + q];
        Bb[e] = (f32x2){(float)(cr * br - ci * bi), (float)(cr * bi + ci * br)}; }
    LAS f32x2* Cc = (LAS f32x2*)(lds + 58368);
    if (tid < 256) { const int dir = tid >> 7, pl = (tid >> 6) & 1, n = tid & 63; const size_t ci_ = ((size_t)((l * 2 + dir) * 32 + g) * 16 + ps * 2 + pl) * 64 + n; Cc[tid] = (f32x2){c_re[ci_], c_im[ci_]}; }
    __syncthreads();
    for (int e = tid; e < 2 * 32 * 2 * 16; e += 512) { const int dir = e >> 10, d = (e >> 5) & 31, pl = (e >> 4) & 1, q = e & 15; float acc = 0.f;
#pragma unroll 8
        for (int n = 0; n < 64; ++n) { const f32x2 w = pw[(dir * 33 + d) * 64 + n], bb = Bb[(dir * 64 + n) * 16 + q], cc = Cc[(dir * 2 + pl) * 64 + n];
            const float zr = w.x * bb.x - w.y * bb.y, zi = w.x * bb.y + w.y * bb.x; acc += cc.x * zr - cc.y * zi; }
        Kt[e] = acc; }
    __syncthreads();
    bf16_t* T = (bf16_t*)(A->ws + WS_T) + (size_t)g * 512 * AS5_PITCH;
    for (int e = tid; e < 64 * 96; e += 512) { const int rr = e / 96, kv = e - rr * 96, j = rr >> 1, pl = rr & 1, p = ps * 2 + pl, k0 = kv * 8; float v[8];
        if (k0 < 512) { const int i = k0 >> 4, q0 = k0 & 15;
#pragma unroll
            for (int t = 0; t < 8; ++t) { const int q = q0 + t; float x = 0.f;
                if (i <= j) x += Kt[((0 * 32 + (j - i)) * 2 + pl) * 16 + q];
                if (i >= j) x += Kt[((1 * 32 + (i - j)) * 2 + pl) * 16 + q];
                if (i == j && q == p) x += dsk[(size_t)l * 512 + g * 16 + p];
                v[t] = x; } }
        else { const int w = (k0 - 512) >> 6, n0 = (k0 - 512) & 63, dir = w >> 1, pidx = dir == 0 ? j + 1 : LC - j; const int gi = (l * 2 + dir) * 32 + g;
#pragma unroll
            for (int t = 0; t < 8; ++t) { const int n = n0 + t; const f32x2 cc = Cc[(dir * 2 + pl) * 64 + n]; const float cr = cc.x, ci = cc.y; const f32x2 a = pw[(dir * 33 + pidx) * 64 + n];
                v[t] = (w & 1) ? -(cr * a.y + ci * a.x) : (cr * a.x - ci * a.y); } }
        u32x4 o; o.x = pk2(v[0], v[1]); o.y = pk2(v[2], v[3]); o.z = pk2(v[4], v[5]); o.w = pk2(v[6], v[7]);
        *(u32x4*)(T + (size_t)(j * 16 + p) * AS5_PITCH + k0) = o; }
    bf16_t* W1 = (bf16_t*)(A->ws + WS_W1) + (size_t)g * 256 * 512;
    for (int e = tid; e < 32 * 64; e += 512) { const int n2 = ps * 32 + (e >> 6), kv = e & 63, k0 = kv * 8, i = k0 >> 4, q0 = k0 & 15; const int dir = n2 >> 7, isim = (n2 >> 6) & 1, n = n2 & 63;
        const int pidx = dir == 0 ? (LC - 1 - i) : i; const f32x2 a = pw[(dir * 33 + pidx) * 64 + n]; float v[8];
#pragma unroll
        for (int t = 0; t < 8; ++t) { const f32x2 bb = Bb[(dir * 64 + n) * 16 + q0 + t]; v[t] = isim ? (a.x * bb.y + a.y * bb.x) : (a.x * bb.x - a.y * bb.y); }
        u32x4 o; o.x = pk2(v[0], v[1]); o.y = pk2(v[2], v[3]); o.z = pk2(v[4], v[5]); o.w = pk2(v[6], v[7]);
        *(u32x4*)(W1 + (size_t)n2 * 512 + k0) = o; }
    __syncthreads();
}

__device__ __forceinline__ void s5_scan(KArgP A, int l, int wid  , int lane) {
    const int g = wid >> 4, b = (wid >> 1) & 7, dir = wid & 1, n = lane; const int gi = (l * 2 + dir) * 32 + g;
    float ar, ai; a_pow(A->in[3][gi * 64 + n], A->in[4][gi * 64 + n], expf(A->in[5][gi]), LC, ar, ai);
    const float* S = (const float*)(A->ws + WS_SST) + ((size_t)g * 1024 + b * 128) * 256 + dir * 128 + n;
    bf16_t* X = (bf16_t*)(A->ws + WS_AS5) + ((size_t)g * 1024 + b * 128) * AS5_PITCH + 512 + dir * 128 + n;
    float xr = 0.f, xi = 0.f;
    for (int c0 = 0; c0 < 128; c0 += 8) {
        float sr[8], si[8];
#pragma unroll
        for (int u = 0; u < 8; ++u) { const int c = dir == 0 ? (c0 + u) : (127 - c0 - u); sr[u] = S[(size_t)c * 256]; si[u] = S[(size_t)c * 256 + 64]; }
#pragma unroll
        for (int u = 0; u < 8; ++u) { const int c = dir == 0 ? (c0 + u) : (127 - c0 - u);
            X[(size_t)c * AS5_PITCH] = (bf16_t)f2bf(xr); X[(size_t)c * AS5_PITCH + 64] = (bf16_t)f2bf(xi);
            const float nr = ar * xr - ai * xi + sr[u], ni = ar * xi + ai * xr + si[u]; xr = nr; xi = ni; }
    }
}

__device__ __forceinline__ void s5_scan4(KArgP A, int l, int seq, int seg, int lane, LAS unsigned char* lds, int slot) {
    const int g = seq >> 4, b = (seq >> 1) & 7, dir = seq & 1, n = lane; const int gi = (l * 2 + dir) * 32 + g;
    const float lre = A->in[3][gi * 64 + n], lim = A->in[4][gi * 64 + n], dt = expf(A->in[5][gi]);
    float ar, ai, sr_, si_; a_pow(lre, lim, dt, LC, ar, ai); a_pow(lre, lim, dt, LC * 32, sr_, si_);
    const float* S = (const float*)(A->ws + WS_SST) + ((size_t)g * 1024 + b * 128) * 256 + dir * 128 + n;
    bf16_t* X = (bf16_t*)(A->ws + WS_AS5) + ((size_t)g * 1024 + b * 128) * AS5_PITCH + 512 + dir * 128 + n;
    float lr[32], li[32]; float xr = 0.f, xi = 0.f;
#pragma unroll
    for (int u0 = 0; u0 < 32; u0 += 8) {
        float sr[8], si[8];
#pragma unroll
        for (int u = 0; u < 8; ++u) { const int cc = seg * 32 + u0 + u, c = dir == 0 ? cc : 127 - cc; sr[u] = S[(size_t)c * 256]; si[u] = S[(size_t)c * 256 + 64]; }
#pragma unroll
        for (int u = 0; u < 8; ++u) { lr[u0 + u] = xr; li[u0 + u] = xi; const float nr = ar * xr - ai * xi + sr[u], ni = ar * xi + ai * xr + si[u]; xr = nr; xi = ni; }
    }
    LAS f32x2* E = (LAS f32x2*)lds + slot * 256;
    E[seg * 64 + n] = (f32x2){xr, xi};
    __syncthreads();
    float cr = 0.f, ci = 0.f;
    for (int j = 0; j < seg; ++j) { const f32x2 e = E[j * 64 + n]; const float nr = sr_ * cr - si_ * ci + e.x, ni = sr_ * ci + si_ * cr + e.y; cr = nr; ci = ni; }
    float pr = 1.f, pi = 0.f;
#pragma unroll
    for (int u = 0; u < 32; ++u) { const int cc = seg * 32 + u, c = dir == 0 ? cc : 127 - cc;
        X[(size_t)c * AS5_PITCH] = (bf16_t)f2bf(lr[u] + pr * cr - pi * ci); X[(size_t)c * AS5_PITCH + 64] = (bf16_t)f2bf(li[u] + pr * ci + pi * cr);
        const float nr = ar * pr - ai * pi, ni = ar * pi + ai * pr; pr = nr; pi = ni; }
    __syncthreads();
}

__device__ __forceinline__ void phase_pool(const bf16_t* up, bf16_t* pooled, int gw, int NGW, int lane) {
    for (int it = gw; it < NB * 256; it += NGW) {
        const int b = it >> 8, tc = it & 255, t0 = tc * 16, grp = lane >> 4, win = 2 << grp, left = win >> 1, right = win - 1 - left;
        const bf16_t* base = up + (size_t)b * SEQ * 512 + lane * 8; bf16_t* ob = pooled + (size_t)b * SEQ * 1024 + 512 + lane * 8;
        int lo = t0 - left < 0 ? 0 : t0 - left, hi = t0 + right + 1 > SEQ ? SEQ : t0 + right + 1;
        f32x4 s0 = {0.f, 0.f, 0.f, 0.f}, s1 = {0.f, 0.f, 0.f, 0.f};
        for (int s = lo; s < hi; ++s) { f32x4 a, c; unpack8(*(const u32x4*)(base + (size_t)s * 512), a, c); s0 += a; s1 += c; }
        for (int t = t0; t < t0 + 16; ++t) {
            f32x4 a, c; unpack8(*(const u32x4*)(base + (size_t)t * 512), a, c); const float inv = 1.0f / (float)(hi - lo);
            *(u32x4*)(ob + (size_t)t * 1024) = pack8(s0 * inv - a, s1 * inv - c);
            if (t + right + 1 < SEQ) { f32x4 x, y; unpack8(*(const u32x4*)(base + (size_t)(t + right + 1) * 512), x, y); s0 += x; s1 += y; ++hi; }
            if (t - left >= 0) { f32x4 x, y; unpack8(*(const u32x4*)(base + (size_t)(t - left) * 512), x, y); s0 -= x; s1 -= y; ++lo; }
        }
    }
}

struct KVFrag { bf16x8 ka0, ka1, kb0, kb1; u32x2 va[4], vb[4]; };
__device__ __forceinline__ void tile_base(int tid, int r, int i0, int& rho, int& ib) {
    if (tid < 10) { const int jt = tid < 2 ? tid + 4 : (tid < 6 ? tid - 2 : tid); rho = r; ib = i0 - 64 + 16 * jt; }
    else if (tid < 22) { const int u = tid - 10, c = u / 3, uu = u - 3 * c; rho = (r + 4 * c) & 15; ib = i0 - 16 + 16 * uu; }
    else { const int v = tid - 22, rs = v / 6, w = v - 6 * rs; rho = 4 * rs; ib = i0 - 4 + 4 * w; }
}
__device__ __forceinline__ int clampi(int x, int lo, int hi) { return x < lo ? lo : (x > hi ? hi : x); }
__device__ __forceinline__ void attn_load(KVFrag& f, int pp, const bf16_t* Kb, const bf16_t* Vb, int r, int i0, int ql, int quad) {
    const int kq = ql >> 2, ks = ql & 3; const bool strided = pp < 11;
    int rho, ib;
    tile_base(2 * pp, r, i0, rho, ib);
    { const int kr = strided ? rho : rho + kq, ki = clampi(strided ? ib + ql : ib + ks, 0, 255); const bf16_t* p = Kb + (kr * 256 + ki) * 64; f.ka0 = *(const bf16x8*)p; f.ka1 = *(const bf16x8*)(p + 32);
      const int vr = strided ? rho : rho + quad, vi = clampi(strided ? ib + 4 * quad : ib, 0, 252) >> 2; const bf16_t* q = Vb + (vr * 64 + vi) * 256;
#pragma unroll
      for (int dt = 0; dt < 4; ++dt) f.va[dt] = *(const u32x2*)(q + dt * 64); }
    tile_base(2 * pp + 1, r, i0, rho, ib);
    { const int kr = strided ? rho : rho + kq, ki = clampi(strided ? ib + ql : ib + ks, 0, 255); const bf16_t* p = Kb + (kr * 256 + ki) * 64; f.kb0 = *(const bf16x8*)p; f.kb1 = *(const bf16x8*)(p + 32);
      const int vr = strided ? rho : rho + quad, vi = clampi(strided ? ib + 4 * quad : ib, 0, 252) >> 2; const bf16_t* q = Vb + (vr * 64 + vi) * 256;
#pragma unroll
      for (int dt = 0; dt < 4; ++dt) f.vb[dt] = *(const u32x2*)(q + dt * 64); }
}
struct AttnState { f32x4 o[4]; f32x4 ol; float m; };
__device__ __forceinline__ void attn_step(AttnState& st, const KVFrag& cur, int pp, bf16x8 qf0, bf16x8 qf1, int r, int i0, int tq, int quad, float nslope2, int lane) {
    const bool strided = pp < 11; const float Rf = pp < 5 ? 1024.f : (pp < 11 ? 256.f : 64.f);
    const float nm = -st.m;
    f32x4 sA = {nm, nm, nm, nm}, sB = {nm, nm, nm, nm};
    sA = __builtin_amdgcn_mfma_f32_16x16x32_bf16(cur.ka0, qf0, sA, 0, 0, 0); sA = __builtin_amdgcn_mfma_f32_16x16x32_bf16(cur.ka1, qf1, sA, 0, 0, 0);
    sB = __builtin_amdgcn_mfma_f32_16x16x32_bf16(cur.kb0, qf0, sB, 0, 0, 0); sB = __builtin_amdgcn_mfma_f32_16x16x32_bf16(cur.kb1, qf1, sB, 0, 0, 0);
    int rho, ib; float dA, dB;
    tile_base(2 * pp, r, i0, rho, ib); { const int rr = strided ? rho : rho + quad, ii = strided ? ib + 4 * quad : ib; dA = ((unsigned)ii < 256u) ? (float)(rr + 16 * ii - tq) : 1e9f; }
    tile_base(2 * pp + 1, r, i0, rho, ib); { const int rr = strided ? rho : rho + quad, ii = strided ? ib + 4 * quad : ib; dB = ((unsigned)ii < 256u) ? (float)(rr + 16 * ii - tq) : 1e9f; }
    float s[8]; float mx = -1e30f;
#pragma unroll
    for (int e = 0; e < 4; ++e) { const float xa = fabsf(dA + 16.f * e), xb = fabsf(dB + 16.f * e);
        s[e] = xa <= Rf ? fmaf(nslope2, xa, sA[e]) : -1e30f; s[4 + e] = xb <= Rf ? fmaf(nslope2, xb, sB[e]) : -1e30f; }
#pragma unroll
    for (int e = 0; e < 8; ++e) mx = fmaxf(mx, s[e]);
    if (pp == 0 || __builtin_amdgcn_ballot_w64(mx > 32.f) != 0ull) {
        mx = fmaxf(mx, shx(mx, 16, lane)); mx = fmaxf(mx, shx(mx, 32, lane));
        const float inc = pp == 0 ? mx : fmaxf(mx, 0.f), alpha = __builtin_amdgcn_exp2f(-inc); st.m += inc; st.ol = st.ol * alpha;
#pragma unroll
        for (int dt = 0; dt < 4; ++dt) st.o[dt] = st.o[dt] * alpha;
#pragma unroll
        for (int e = 0; e < 8; ++e) s[e] -= inc;
    }
    float p[8];
#pragma unroll
    for (int e = 0; e < 8; ++e) p[e] = __builtin_amdgcn_exp2f(s[e]);
    u32x4 pk; pk.x = cvt_pk_bf16(p[0], p[1]); pk.y = cvt_pk_bf16(p[2], p[3]); pk.z = cvt_pk_bf16(p[4], p[5]); pk.w = cvt_pk_bf16(p[6], p[7]);
    const bf16x8 pf = __builtin_bit_cast(bf16x8, pk);
    const u32x4 one4 = {0x3F803F80u, 0x3F803F80u, 0x3F803F80u, 0x3F803F80u};
    st.ol = __builtin_amdgcn_mfma_f32_16x16x32_bf16(__builtin_bit_cast(bf16x8, one4), pf, st.ol, 0, 0, 0);
#pragma unroll
    for (int dt = 0; dt < 4; ++dt) { u32x4 vv; vv.x = cur.va[dt].x; vv.y = cur.va[dt].y; vv.z = cur.vb[dt].x; vv.w = cur.vb[dt].y;
        st.o[dt] = __builtin_amdgcn_mfma_f32_16x16x32_bf16(__builtin_bit_cast(bf16x8, vv), pf, st.o[dt], 0, 0, 0); }
}
constexpr int ATT_KROW = 144;
constexpr int ATT_LDS_V = 16 * 24 * ATT_KROW;
__device__ __forceinline__ void attn_stage_window(LAS unsigned char* lds, const bf16_t* Kbh, const bf16_t* Vbh, int i0, int tid) {
    u32x4 kv[6], vv[6];
#pragma unroll
    for (int u = 0; u < 6; ++u) { const int t = tid + 512 * u, rho = t / 192, rem = t - rho * 192, irow = rem >> 3, c = rem & 7; const int i = clampi(i0 - 4 + irow, 0, 255);
        kv[u] = *(const u32x4*)(Kbh + (rho * 256 + i) * 64 + c * 8); }
#pragma unroll
    for (int u = 0; u < 6; ++u) { const int t = tid + 512 * u, rho = t / 192, rem = t - rho * 192, blk = rem >> 5, c = rem & 31; const int i4 = clampi((i0 >> 2) - 1 + blk, 0, 63);
        vv[u] = *(const u32x4*)(Vbh + (rho * 64 + i4) * 256 + c * 8); }
#pragma unroll
    for (int u = 0; u < 6; ++u) { const int t = tid + 512 * u, rho = t / 192, rem = t - rho * 192, irow = rem >> 3, c = rem & 7; *(LAS u32x4*)(lds + (rho * 24 + irow) * ATT_KROW + c * 16) = kv[u]; }
#pragma unroll
    for (int u = 0; u < 6; ++u) { const int t = tid + 512 * u, rho = t / 192, rem = t - rho * 192, blk = rem >> 5, c = rem & 31; *(LAS u32x4*)(lds + ATT_LDS_V + (rho * 6 + blk) * 512 + c * 16) = vv[u]; }
}
__device__ __forceinline__ void attn_load_lds(KVFrag& f, int pp, LAS unsigned char* lds, int ql, int quad) {
    const int kq = ql >> 2, ks = ql & 3;
#pragma unroll
    for (int half = 0; half < 2; ++half) { const int v = 2 * pp + half - 22, rs = v / 6, w = v - 6 * rs;
        const LAS unsigned char* kp = lds + ((4 * rs + kq) * 24 + 4 * w + ks) * ATT_KROW + quad * 16;
        const bf16x8 k0 = *(const LAS bf16x8*)kp, k1 = *(const LAS bf16x8*)(kp + 64);
        const LAS unsigned char* vp = lds + ATT_LDS_V + ((4 * rs + quad) * 6 + w) * 512 + ql * 8;
        u32x2 vv[4];
#pragma unroll
        for (int dt = 0; dt < 4; ++dt) vv[dt] = *(const LAS u32x2*)(vp + dt * 128);
        if (half == 0) { f.ka0 = k0; f.ka1 = k1; f.va[0] = vv[0]; f.va[1] = vv[1]; f.va[2] = vv[2]; f.va[3] = vv[3]; }
        else { f.kb0 = k0; f.kb1 = k1; f.vb[0] = vv[0]; f.vb[1] = vv[1]; f.vb[2] = vv[2]; f.vb[3] = vv[3]; } }
}
__device__ __forceinline__ void attn_group(const bf16_t* Q, const bf16_t* Kp, const bf16_t* Vt, bf16_t* O, int b, int h, int r, int i0, int lane, LAS unsigned char* lds) {
    const int ql = lane & 15, quad = lane >> 4;
    const int tq = r + 16 * (i0 + ql);
    const float nslope2 = -exp2f(-0.5f * (float)(h + 1)) * LOG2E;
    const size_t qrow = ((size_t)b * SEQ + tq) * 1024 + h * 64;
    const bf16x8 qf0 = *(const bf16x8*)(Q + qrow + quad * 8), qf1 = *(const bf16x8*)(Q + qrow + 32 + quad * 8);
    const bf16_t* Kb = Kp + (size_t)(b * 16 + h) * 262144 + quad * 8;
    const bf16_t* Vb = Vt + (size_t)(b * 16 + h) * 262144 + ql * 4;
    AttnState st;
#pragma unroll
    for (int dt = 0; dt < 4; ++dt) st.o[dt] = (f32x4){0.f, 0.f, 0.f, 0.f};
    st.m = 0.f; st.ol = (f32x4){0.f, 0.f, 0.f, 0.f};
    KVFrag fa, fb, fc;
    attn_load(fa, 0, Kb, Vb, r, i0, ql, quad); attn_load(fb, 1, Kb, Vb, r, i0, ql, quad);
    for (int pp = 0; pp < 9; pp += 3) {
        attn_load(fc, pp + 2, Kb, Vb, r, i0, ql, quad); attn_step(st, fa, pp, qf0, qf1, r, i0, tq, quad, nslope2, lane);
        attn_load(fa, pp + 3, Kb, Vb, r, i0, ql, quad); attn_step(st, fb, pp + 1, qf0, qf1, r, i0, tq, quad, nslope2, lane);
        if (pp + 4 < 11) attn_load(fb, pp + 4, Kb, Vb, r, i0, ql, quad);
        attn_step(st, fc, pp + 2, qf0, qf1, r, i0, tq, quad, nslope2, lane);
    }
    attn_step(st, fa, 9, qf0, qf1, r, i0, tq, quad, nslope2, lane); attn_step(st, fb, 10, qf0, qf1, r, i0, tq, quad, nslope2, lane);
#pragma unroll 1
    for (int pp = 11; pp < 23; ++pp) { attn_load_lds(fa, pp, lds, ql, quad); attn_step(st, fa, pp, qf0, qf1, r, i0, tq, quad, nslope2, lane); }
    const float inv = 1.0f / st.ol[0];
#pragma unroll
    for (int dt = 0; dt < 4; ++dt) { u32x2 w; w.x = cvt_pk_bf16(st.o[dt][0] * inv, st.o[dt][1] * inv); w.y = cvt_pk_bf16(st.o[dt][2] * inv, st.o[dt][3] * inv);
        *(u32x2*)(O + qrow + dt * 16 + 4 * quad) = w; }
}
__device__ __forceinline__ void phase_attn(const bf16_t* Q, const bf16_t* Kp, const bf16_t* Vt, bf16_t* O, int vcu, int G, int wave, int lane, LAS unsigned char* lds) {
    const int per_x = G >> 3, xcd = vcu / per_x, j = vcu - xcd * per_x;
    const int gpr = per_x * 16;
    for (int g0 = 0; g0 < 16 * 256; g0 += gpr) {
        const int gi0 = g0 + j * 16, bh = xcd * 16 + (gi0 >> 8), i0 = ((gi0 & 255) >> 4) * 16, b = bh >> 4, h = bh & 15;
        __syncthreads();
        { int t_ = wave * 64 + lane; asm volatile("" : "+v"(t_));
          attn_stage_window(lds, Kp + (size_t)bh * 262144, Vt + (size_t)bh * 262144, i0, t_); }
        __syncthreads();
#pragma unroll 1
        for (int k = 0; k < 2; ++k) { int l_ = lane; asm volatile("" : "+v"(l_)); attn_group(Q, Kp, Vt, O, b, h, k * 8 + wave, i0, l_, lds); }
    }
}

#define XB_TMO      128
#define XB_XCNT(j)  (256  + 64 * (j))
#define XB_XSUB(j)  (1280 + 64 * (j))
#define XB_XGEN(j)  (2304 + 64 * (j))
#define XB_TOP      3328
#define XB_TOPGEN   3392
#define XCD_BAR_WORDS 3456
#define XB_SPIN_CAP (1u << 18)

__device__ __forceinline__ unsigned xb_ld(unsigned* p)              { return __hip_atomic_load(p, __ATOMIC_RELAXED, __HIP_MEMORY_SCOPE_AGENT); }
__device__ __forceinline__ unsigned xb_add(unsigned* p, unsigned v) { return __hip_atomic_fetch_add(p, v, __ATOMIC_RELAXED, __HIP_MEMORY_SCOPE_AGENT); }
__device__ __forceinline__ unsigned xb_xcc_id() { return (unsigned)__builtin_amdgcn_s_getreg((3 << 11) | 20) & 0xFu; }
#define XB_SPIN(cond, bar) do { unsigned _sp = 0; while (cond) { __builtin_amdgcn_s_sleep(1); \
    if ((++_sp & 255u) == 0u) { if (xb_ld(&(bar)[XB_TMO])) break; if (_sp > XB_SPIN_CAP) { atomicAdd(&(bar)[XB_TMO], 1u); break; } } } } while (0)

struct XcdBarrier {
    unsigned* bar; unsigned x;
    volatile LAS unsigned* st;
};

__device__ __forceinline__ XcdBarrier xcd_barrier_post(unsigned* bar, volatile LAS unsigned* st) {
    XcdBarrier b; b.bar = bar; b.x = xb_xcc_id(); b.st = st;
    if (threadIdx.x == 0) (void)xb_add(&bar[XB_XCNT(b.x)], 1u);
    return b;
}
__device__ __forceinline__ void xcd_barrier_complete(unsigned* bar, unsigned x, unsigned& nloc, unsigned& nx) {
    const unsigned G = gridDim.x * gridDim.y * gridDim.z;
    unsigned sum, cnt, mine, sp = 0u;
    for (;;) {
        sum = 0u; cnt = 0u; mine = 0u;
#pragma unroll
        for (unsigned j = 0; j < 16; ++j) { const unsigned c = xb_ld(&bar[XB_XCNT(j)]); sum += c; cnt += (c > 0u) ? 1u : 0u; mine = (j == x) ? c : mine; }
        if (sum == G) break;
        __builtin_amdgcn_s_sleep(1);
        if ((++sp & 255u) == 0u) { if (xb_ld(&bar[XB_TMO])) break; if (sp > XB_SPIN_CAP) { atomicAdd(&bar[XB_TMO], 1u); break; } }
    }
    nloc = mine > 0u ? mine : 1u; nx = cnt > 0u ? cnt : 1u;
}

__device__ __forceinline__ void xcd_barrier(const XcdBarrier& b) {
    asm volatile("s_waitcnt vmcnt(0)" ::: "memory");
    __syncthreads();
    if (threadIdx.x == 0) {
        unsigned* bar = b.bar;
        __builtin_amdgcn_s_waitcnt(0);
        unsigned nloc = b.st[0], nx = b.st[1];
        if (nloc == 0u) { xcd_barrier_complete(bar, b.x, nloc, nx); b.st[0] = nloc; b.st[1] = nx; }
        const unsigned old = xb_add(&bar[XB_XSUB(b.x)], 1u);
        const unsigned gen = old / nloc;
        if (old + 1u == (gen + 1u) * nloc) {
            __builtin_amdgcn_fence(__ATOMIC_RELEASE, "agent");
            asm volatile("s_waitcnt vmcnt(0)" ::: "memory");
            const unsigned og = xb_add(&bar[XB_TOP], 1u);
            const unsigned tg = og / nx;
            if (og + 1u == (tg + 1u) * nx) xb_add(&bar[XB_TOPGEN], 1u);
            else XB_SPIN(xb_ld(&bar[XB_TOPGEN]) == tg, bar);
            __builtin_amdgcn_fence(__ATOMIC_ACQUIRE, "agent");
            xb_add(&bar[XB_XGEN(b.x)], 1u);
            asm volatile("s_waitcnt vmcnt(0)" ::: "memory");
        } else {
            XB_SPIN(xb_ld(&bar[XB_XGEN(b.x)]) == gen, bar);
            __builtin_amdgcn_fence(__ATOMIC_ACQUIRE, "agent");
            asm volatile("s_waitcnt vmcnt(0)" ::: "memory");
        }
    }
    __syncthreads();
}


#define XN ((bf16_t*)(ws + WS_XN))
#define UPOOL ((bf16_t*)(ws + WS_UPOOL))
#define AS5 ((bf16_t*)(ws + WS_AS5))
#define Qb ((bf16_t*)(ws + WS_Q))
#define Kb ((bf16_t*)(ws + WS_K))
#define VT ((bf16_t*)(ws + WS_VT))
#define SST ((float*)(ws + WS_SST))
#define POOLED ((bf16_t*)(ws + WS_POOLED))
#define YS5 ((bf16_t*)(ws + WS_YS5))
#define GT ((bf16_t*)(ws + WS_GT))
#define MERGED ((bf16_t*)(ws + WS_MERGED))
#define Yb ((bf16_t*)(ws + WS_Y))
#define HID ((bf16_t*)(ws + WS_HID))
#define Tt ((bf16_t*)(ws + WS_T))
#define W1t ((bf16_t*)(ws + WS_W1))
#define run_gemm(lds, S, K, lda, ldb, ...) run_gemm_(lds, S, K, lda, ldb, __VA_ARGS__, tid)
#ifndef BR_N
#define BR_N 2
#endif
#ifndef PHMASK
#define PHMASK 0xFFFF
#endif
constexpr int NSUB = 11;
constexpr int NPH = 1 + NSUB * NLAYER + 1;
constexpr int NOB = 1 << 30;
constexpr unsigned T1K = 256u * 1024 * 2, T512 = 256u * 512 * 2, TAS5 = 256u * AS5_PITCH * 2, T4K = 256u * 4096 * 2;
typedef pg8::SchedT<MTOK / 256, 12, MTOK / 256, NOB, 0u, T1K, 0u, T1K, 0u> SchedIn;
typedef pg8::SchedT<4, MTOK / 256, 4, 16, 0u, T1K, 0u, 1024u * 2, (unsigned)SEQ * 1024 * 2> SchedVt;
typedef pg8::SchedT<128, 1, 4, NOB, 1024u * AS5_PITCH * 2, TAS5, 256u * 512 * 2, 0u, 0u> SchedS1;
typedef pg8::SchedT<128, 2, 4, NOB, 1024u * AS5_PITCH * 2, TAS5, 512u * AS5_PITCH * 2, TAS5, 0u> SchedS3;
typedef pg8::SchedT<MTOK / 256, 2, MTOK / 256, NOB, 0u, T512, 0u, T512, 0u> SchedGlu;
typedef pg8::SchedT<MTOK / 256, 4, MTOK / 256, NOB, 0u, T1K, 0u, T1K, 0u> Sched1k;
typedef pg8::SchedT<MTOK / 256, 4, MTOK / 256, NOB, 0u, T512, 0u, T512, 0u> Sched512;
typedef pg8::SchedT<MTOK / 256, 16, MTOK / 256, NOB, 0u, T1K, 0u, T1K, 0u> SchedUp;
typedef pg8::SchedT<MTOK / 256, 4, MTOK / 256, NOB, 0u, T4K, 0u, T4K, 0u> SchedDn;
#define CP(x) ((const char*)(x))
__global__ void __launch_bounds__(512, 2) fwd_kernel(Args Araw) {
    extern __shared__ __attribute__((aligned(16))) unsigned char lds_raw[];
    LAS unsigned char* lds = (LAS unsigned char*)lds_raw;
    const int ph_hi = Araw.ph_hi; const int wave0 = __builtin_amdgcn_readfirstlane(threadIdx.x >> 6);
    volatile LAS unsigned* bst = (volatile LAS unsigned*)(lds + 131072 + 64);
    if (threadIdx.x < 2) bst[threadIdx.x] = 0u;
    __syncthreads();
    XcdBarrier xbar; xbar.bar = (unsigned*)Araw.ws; xbar.x = 0; xbar.st = bst;
    if (ph_hi - Araw.ph_lo > 1) xbar = xcd_barrier_post((unsigned*)Araw.ws, bst);
    for (int ph = Araw.ph_lo; ph < ph_hi; ++ph) {
        KArgP A = (KArgP)__builtin_amdgcn_kernarg_segment_ptr(); asm volatile("" : "+s"(A));
        unsigned char* ws = A->ws; float* hres = A->out;
        int lane, wave = wave0, bx = blockIdx.x;
        asm volatile("v_mbcnt_lo_u32_b32 %0, -1, 0\n\tv_mbcnt_hi_u32_b32 %0, -1, %0" : "=v"(lane)); asm volatile("" : "+s"(wave)); asm volatile("" : "+s"(bx));
        const int tid = wave * 64 + lane;
        const int G = gridDim.x, vcu = (G % 8 == 0) ? (bx % 8) * (G / 8) + bx / 8 : bx;
        const int gw = vcu * 8 + wave, NGW = G * 8, gtid = bx * 512 + tid, NT = G * 512;
        if (ph == 0) { if constexpr ((PHMASK >> 11) & 1) phase_convert(A, lds, gw, NGW, wave, lane, gtid, NT); }
        else if (ph == NPH - 1) { phase_norm<2>(hres, A->in[21], nullptr, hres, gw, NGW, lane); }
        else {
            const int l = (ph - 1) / NSUB, sub = (ph - 1) % NSUB;
            const bf16_t* WL = (const bf16_t*)(ws + WS_W + (size_t)l * W_LAYER_STRIDE);
            switch (sub) {
            case 0: if constexpr ((PHMASK >> 0) & 1) {
                for (int it = bx; it < 256; it += G) s5_tables(A, l, it >> 3, it & 7, lds, tid);
                if (l == 0) phase_norm<1>(A->in[0], A->in[1], XN, hres, gw, NGW, lane); else phase_norm<0>(hres, A->in[1] + (size_t)l * DM, XN, nullptr, gw, NGW, lane);
            } break;
            case 1: if constexpr ((PHMASK >> 1) & 1) {
                { SchedIn S{G, bx, CP(XN), CP(WL + W_IN)}; run_gemm(lds, S, 1024, 1024, 1024, FG1{AS5, UPOOL, Qb, Kb}); }
                { SchedVt S{G, bx, CP(WL + W_IN + (size_t)3072 * 1024), CP(XN)}; run_gemm(lds, S, 1024, 1024, 16 * 1024, FVt{VT}); }
            } break;
            case 2: if constexpr ((PHMASK >> 2) & 1) {
                { SchedS1 S{G, bx, CP(AS5), CP(W1t)}; run_gemm(lds, S, 512, AS5_PITCH, 512, FS1{SST}); }
                phase_attn(Qb, Kb, VT, Qb, vcu, G, wave, lane, lds);
            } break;
            case 3: if constexpr ((PHMASK >> 3) & 1) {
                for (int w0 = bx * 2; w0 < 512; w0 += G * 2) s5_scan4(A, l, w0 + (wave >> 2), wave & 3, lane, lds, wave >> 2);
                phase_pool(UPOOL, POOLED, gw, NGW, lane);
            } break;
            case 4: if constexpr ((PHMASK >> 4) & 1) {
                SchedS3 S{G, bx, CP(AS5), CP(Tt)}; run_gemm(lds, S, AS5_PITCH, AS5_PITCH, AS5_PITCH, FS3{Yb});
            } break;
            case 5: if constexpr ((PHMASK >> 5) & 1) {
                SchedGlu S{G, bx, CP(Yb), CP(WL + W_GLU)}; run_gemm(lds, S, 512, 512, 512, FGlu{Yb, YS5});
            } break;
            case 6: {
                pg8::SchedBr S{G, bx, CP(XN), CP(YS5), CP(Qb), CP(WL + W_IN + (size_t)4096 * 1024), CP(WL + W_BS), CP(WL + W_BA)};
                pg8::Gemm g{1024, 1024, 1024}; pg8::EpiBr E{GT, MERGED};
                { int tid_ = tid; __builtin_amdgcn_fence(__ATOMIC_ACQUIRE, "agent"); asm volatile("" : "+v"(tid_)); pg8::gemm_phase<pg8::EpiBr, pg8::SchedBr, true, true>(lds, g, S, E, tid_); }
            } break;
            case 7: { Sched1k S{G, bx, CP(MERGED), CP(WL + W_OUT)}; run_gemm(lds, S, 1024, 1024, 1024, FResid{hres}); } break;
            case 8: { phase_norm<0>(hres, A->in[18] + (size_t)l * DM, XN, nullptr, gw, NGW, lane); } break;
            case 9: { SchedUp S{G, bx, CP(XN), CP(WL + W_UP)}; run_gemm(lds, S, 1024, 1024, 1024, FUp{HID}); } break;
            case 10: { SchedDn S{G, bx, CP(HID), CP(WL + W_DN)}; run_gemm(lds, S, 4096, 4096, 4096, FResid{hres}); } break;
            }
        }
        if (ph + 1 < ph_hi && ph != 0) {
            if (ph_hi < 0) { __threadfence(); cg::this_grid().sync(); }
            { XcdBarrier xb; xb.bar = (unsigned*)A->ws; xb.x = xb_xcc_id(); xb.st = bst; xcd_barrier(xb); }
        }
    }
}

#ifndef LAST_PH
#define LAST_PH (NPH - 1)
#endif
#ifdef DUMP_OFF
__global__ void dump_kernel(const unsigned short* src, float* dst, size_t n) { for (size_t i = (size_t)blockIdx.x * blockDim.x + threadIdx.x; i < n; i += (size_t)gridDim.x * blockDim.x) dst[i] = __uint_as_float((unsigned)src[i] << 16); }
#endif
extern "C" void kernel_launch(void* const* d_in, const int* in_sizes, int n_in, void* d_out, int out_size, void* d_ws, size_t ws_size, hipStream_t stream) {
    static int grid = 0;
    if (grid == 0) {
        if (n_in != 22 || out_size != MTOK * DM || ws_size < WS_END) { fprintf(stderr, "kernel_launch: unexpected shapes (n_in %d, out %d, ws %zu < %zu)\n", n_in, out_size, ws_size, (size_t)WS_END); grid = -1; return; }
        int dev = 0, cus = 0, per_cu = 0;
        hipGetDevice(&dev); hipDeviceGetAttribute(&cus, hipDeviceAttributeMultiprocessorCount, dev);
        if (hipFuncSetAttribute((const void*)fwd_kernel, hipFuncAttributeMaxDynamicSharedMemorySize, LDS_BYTES) != hipSuccess) { fprintf(stderr, "kernel_launch: hipFuncSetAttribute failed\n"); grid = -1; return; }
        hipOccupancyMaxActiveBlocksPerMultiprocessor(&per_cu, (const void*)fwd_kernel, 512, LDS_BYTES);
        (void)hipGetLastError();
        if (per_cu < 1) fprintf(stderr, "kernel_launch: occupancy query says %d blocks per CU\n", per_cu);
        grid = cus;
        if (grid != 256) fprintf(stderr, "kernel_launch: %d CUs (tuned for 256)\n", grid);
        while ((NB * 16 * 256) % grid != 0 || grid % 8 != 0) --grid;
    }
    if (grid < 0) return;
    (void)hipMemsetAsync(d_ws, 0, 65536, stream);
    Args a{};
    for (int i = 0; i < 22; ++i) a.in[i] = (const float*)d_in[i];
    a.out = (float*)d_out; a.ws = (unsigned char*)d_ws;
#if ONE_LAUNCH
    a.ph_lo = 0; a.ph_hi = NPH;
    void* args[] = {&a};
    hipError_t e = hipLaunchCooperativeKernel((const void*)fwd_kernel, dim3(grid), dim3(512), args, LDS_BYTES, stream);
    if (e != hipSuccess) fprintf(stderr, "cooperative launch failed: %s (grid %d)\n", hipGetErrorString(e), grid);
#else
    for (int ph = 0; ph <= LAST_PH; ++ph) { a.ph_lo = ph; a.ph_hi = ph + 1; hipLaunchKernelGGL(fwd_kernel, dim3(grid), dim3(512), LDS_BYTES, stream, a); }
#ifdef DUMP_OFF
    hipLaunchKernelGGL(dump_kernel, dim3(2048), dim3(256), 0, stream, (const unsigned short*)((const char*)d_ws + (size_t)(DUMP_OFF)), (float*)d_out, (size_t)MTOK * DM);
#endif
#endif
}
```
